# Optimizing an MI355X kernel written in HIP

```python
import jax, jax.numpy as jnp
from jax import lax
import numpy as np

D_MODEL = 1024
BATCH = 8
SEQ = 4096
DEPTH = 2

FOX_HEADS = 8
FOX_HEAD_DIM = 64
FOX_WIDTH = FOX_HEADS * FOX_HEAD_DIM
MLA_HEADS = 8
MLA_NOPE_DIM = 64
MLA_ROPE_DIM = 32
MLA_V_DIM = 64
MLA_WIDTH = MLA_HEADS * MLA_V_DIM
D_MIX = FOX_WIDTH + MLA_WIDTH
Q_LORA_RANK = 256
KV_LORA_RANK = 128
ROPE_THETA = 10000.0
IN_WIDTH = 3 * FOX_WIDTH + FOX_HEADS + Q_LORA_RANK + KV_LORA_RANK + MLA_ROPE_DIM
Q_BLOCK = 128
N_GROUPS = 8
EXPERTS_PER_GROUP = 4
N_EXPERTS = N_GROUPS * EXPERTS_PER_GROUP
TOP_K_IN_GROUP = 2
D_EXPERT = 256
EXPERT_BLOCK = 128
NORM_EPS = 1e-6

kernel_name = 'hybrid_fox_mla_hmoe'


def rms_norm(x, gain):
    xf = x.astype(jnp.float32)
    y = xf * lax.rsqrt(jnp.mean(xf * xf, axis=-1, keepdims=True) + NORM_EPS)
    return (y * gain.astype(jnp.float32)).astype(x.dtype)


def rotary(x, positions):
    half = MLA_ROPE_DIM // 2
    inv_freq = ROPE_THETA ** (-jnp.arange(half, dtype=jnp.float32) / half)
    ang = positions.astype(jnp.float32)[..., None] * inv_freq
    ang = ang.reshape(ang.shape[:2] + (1,) * (x.ndim - 3) + (half,))
    cos, sin = jnp.cos(ang), jnp.sin(ang)
    xf = x.astype(jnp.float32)
    x1, x2 = xf[..., :half], xf[..., half:]
    return jnp.concatenate([x1 * cos - x2 * sin, x2 * cos + x1 * sin], axis=-1).astype(x.dtype)


def causal_block_attention(q, k, v, log_forget_cum=None):
    B, S, H, dk = q.shape
    dv = v.shape[-1]
    nb = S // Q_BLOCK
    scale = dk ** -0.5
    kf = k.astype(jnp.float32)
    vf = v.astype(jnp.float32)
    key_pos = jnp.arange(S)
    q_blocks = q.reshape(B, nb, Q_BLOCK, H, dk).transpose(1, 0, 2, 3, 4)
    has_decay = log_forget_cum is not None
    if has_decay:
        d_keys = log_forget_cum.transpose(0, 2, 1)
        d_blocks = log_forget_cum.reshape(B, nb, Q_BLOCK, H).transpose(1, 0, 3, 2)
        xs = (jnp.arange(nb), q_blocks, d_blocks)
    else:
        xs = (jnp.arange(nb), q_blocks)

    def one_block(args):
        i, q_i = args[0], args[1]
        s = jnp.einsum('bqhd,bkhd->bhqk', q_i.astype(jnp.float32), kf) * scale
        if has_decay:
            s = s + args[2][..., :, None] - d_keys[:, :, None, :]
        q_pos = i * Q_BLOCK + jnp.arange(Q_BLOCK)
        s = jnp.where(key_pos[None, :] <= q_pos[:, None], s, -jnp.inf)
        p = jax.nn.softmax(s, axis=-1)
        return jnp.einsum('bhqk,bkhd->bqhd', p, vf)

    out = lax.map(one_block, xs)
    return out.transpose(1, 0, 2, 3, 4).reshape(B, S, H, dv).astype(v.dtype)


def hybrid_mixer(xn, positions, w_in, b_f, q_norm, w_uq, kv_norm, w_ukv, fox_out_norm, mla_out_norm, w_o):
    B, S, _ = xn.shape
    proj = xn @ w_in
    offs = [FOX_WIDTH, 2 * FOX_WIDTH, 3 * FOX_WIDTH, 3 * FOX_WIDTH + FOX_HEADS,
            3 * FOX_WIDTH + FOX_HEADS + Q_LORA_RANK,
            3 * FOX_WIDTH + FOX_HEADS + Q_LORA_RANK + KV_LORA_RANK]
    fq, fk, fv, f_logit, c_q, c_kv, k_rope = jnp.split(proj, offs, axis=-1)

    log_f = jax.nn.log_sigmoid(f_logit.astype(jnp.float32) + b_f.astype(jnp.float32))
    log_f_cum = jnp.cumsum(log_f, axis=1)
    fox = causal_block_attention(fq.reshape(B, S, FOX_HEADS, FOX_HEAD_DIM),
                                 fk.reshape(B, S, FOX_HEADS, FOX_HEAD_DIM),
                                 fv.reshape(B, S, FOX_HEADS, FOX_HEAD_DIM), log_f_cum)
    fox = rms_norm(fox, fox_out_norm.reshape(FOX_HEADS, FOX_HEAD_DIM)).reshape(B, S, FOX_WIDTH)

    q = (rms_norm(c_q, q_norm) @ w_uq).reshape(B, S, MLA_HEADS, MLA_NOPE_DIM + MLA_ROPE_DIM)
    q = jnp.concatenate([q[..., :MLA_NOPE_DIM], rotary(q[..., MLA_NOPE_DIM:], positions)], axis=-1)
    kv = (rms_norm(c_kv, kv_norm) @ w_ukv).reshape(B, S, MLA_HEADS, MLA_NOPE_DIM + MLA_V_DIM)
    k_nope, v = kv[..., :MLA_NOPE_DIM], kv[..., MLA_NOPE_DIM:]
    k_pe = rotary(k_rope, positions)
    k = jnp.concatenate([k_nope, jnp.broadcast_to(k_pe[:, :, None, :], (B, S, MLA_HEADS, MLA_ROPE_DIM))], axis=-1)
    mla = causal_block_attention(q, k, v)
    mla = rms_norm(mla, mla_out_norm.reshape(MLA_HEADS, MLA_V_DIM)).reshape(B, S, MLA_WIDTH)

    return jnp.concatenate([fox, mla], axis=-1) @ w_o


def hierarchical_moe(xn, w_group, w_router, w_gate, w_up, w_down):
    B, S, D = xn.shape
    T = B * S
    xt = xn.reshape(T, D)
    group_p = jax.nn.softmax((xt @ w_group).astype(jnp.float32), axis=-1)
    group_w, group_id = lax.top_k(group_p, 1)
    expert_logits = (xt @ w_router).astype(jnp.float32).reshape(T, N_GROUPS, EXPERTS_PER_GROUP)
    in_group = jnp.take_along_axis(expert_logits, group_id[:, :, None], axis=1)[:, 0]
    top_logits, local_id = lax.top_k(in_group, TOP_K_IN_GROUP)
    gates = group_w * jax.nn.softmax(top_logits, axis=-1)
    expert_id = group_id * EXPERTS_PER_GROUP + local_id

    A = T * TOP_K_IN_GROUP
    e_flat = expert_id.reshape(A)
    tok_flat = jnp.repeat(jnp.arange(T), TOP_K_IN_GROUP)
    g_flat = gates.reshape(A)
    order = jnp.argsort(e_flat)
    e_sorted, tok_sorted, g_sorted = e_flat[order], tok_flat[order], g_flat[order]
    counts = jnp.bincount(e_flat, length=N_EXPERTS)
    padded = (counts + EXPERT_BLOCK - 1) // EXPERT_BLOCK * EXPERT_BLOCK
    start = jnp.cumsum(counts) - counts
    pend = jnp.cumsum(padded)
    pstart = pend - padded
    dest = pstart[e_sorted] + (jnp.arange(A) - start[e_sorted])
    n_blocks = (A + N_EXPERTS * (EXPERT_BLOCK - 1) + EXPERT_BLOCK - 1) // EXPERT_BLOCK
    buf = jnp.zeros((n_blocks * EXPERT_BLOCK, D), xn.dtype).at[dest].set(xt[tok_sorted])
    block_expert = jnp.clip(jnp.searchsorted(pend, jnp.arange(n_blocks) * EXPERT_BLOCK, side='right'), 0, N_EXPERTS - 1)

    def expert_block(args):
        xb, e = args
        h = jax.nn.silu(xb @ w_gate[e]) * (xb @ w_up[e])
        return h @ w_down[e]

    ybuf = lax.map(expert_block, (buf.reshape(n_blocks, EXPERT_BLOCK, D), block_expert)).reshape(-1, D)
    contrib = ybuf[dest].astype(jnp.float32) * g_sorted[:, None]
    y = jax.ops.segment_sum(contrib, tok_sorted, num_segments=T)
    return y.reshape(B, S, D).astype(xn.dtype)


def setup_inputs(seed: int = 0) -> dict:
    key = jax.random.key(seed)
    ks = jax.random.split(key, 20)
    f32 = jnp.float32

    def dense(k, shape, fan_in):
        return jax.random.normal(k, shape, f32) * (fan_in ** -0.5)

    def gain(k, shape):
        return 1.0 + 0.02 * jax.random.normal(k, shape, f32)

    return {
        'x': jax.random.normal(ks[0], (BATCH, SEQ, D_MODEL), f32),
        'positions': jnp.broadcast_to(jnp.arange(SEQ, dtype=jnp.int32), (BATCH, SEQ)),
        'attn_norm': gain(ks[1], (DEPTH, D_MODEL)),
        'w_in': dense(ks[2], (DEPTH, D_MODEL, IN_WIDTH), D_MODEL),
        'b_f': jax.random.uniform(ks[3], (DEPTH, FOX_HEADS), f32, 1.0, 4.0),
        'q_norm': gain(ks[4], (DEPTH, Q_LORA_RANK)),
        'w_uq': dense(ks[5], (DEPTH, Q_LORA_RANK, MLA_HEADS * (MLA_NOPE_DIM + MLA_ROPE_DIM)), Q_LORA_RANK),
        'kv_norm': gain(ks[6], (DEPTH, KV_LORA_RANK)),
        'w_ukv': dense(ks[7], (DEPTH, KV_LORA_RANK, MLA_HEADS * (MLA_NOPE_DIM + MLA_V_DIM)), KV_LORA_RANK),
        'fox_out_norm': gain(ks[8], (DEPTH, FOX_WIDTH)),
        'mla_out_norm': gain(ks[9], (DEPTH, MLA_WIDTH)),
        'w_o': dense(ks[10], (DEPTH, D_MIX, D_MODEL), D_MIX),
        'ffn_norm': gain(ks[11], (DEPTH, D_MODEL)),
        'w_group': dense(ks[12], (DEPTH, D_MODEL, N_GROUPS), D_MODEL),
        'w_router': dense(ks[13], (DEPTH, D_MODEL, N_EXPERTS), D_MODEL),
        'w_gate': dense(ks[14], (DEPTH, N_EXPERTS, D_MODEL, D_EXPERT), D_MODEL),
        'w_up': dense(ks[15], (DEPTH, N_EXPERTS, D_MODEL, D_EXPERT), D_MODEL),
        'w_down': dense(ks[16], (DEPTH, N_EXPERTS, D_EXPERT, D_MODEL), D_EXPERT),
        'final_norm': gain(ks[17], (D_MODEL,)),
    }


def reference(x, positions, attn_norm, w_in, b_f, q_norm, w_uq, kv_norm, w_ukv, fox_out_norm, mla_out_norm, w_o,
              ffn_norm, w_group, w_router, w_gate, w_up, w_down, final_norm):
    h = x
    for l in range(DEPTH):
        h = h + hybrid_mixer(rms_norm(h, attn_norm[l]), positions, w_in[l], b_f[l], q_norm[l], w_uq[l],
                             kv_norm[l], w_ukv[l], fox_out_norm[l], mla_out_norm[l], w_o[l])
        h = h + hierarchical_moe(rms_norm(h, ffn_norm[l]), w_group[l], w_router[l], w_gate[l], w_up[l], w_down[l])
    return rms_norm(h, final_norm)
```

```cpp
#include <hip/hip_runtime.h>
#include <cstdio>
#include <cstdint>
#include <cmath>

typedef unsigned short bf16_t;
typedef unsigned u32x4 __attribute__((ext_vector_type(4)));
typedef float f32x4 __attribute__((ext_vector_type(4)));

constexpr int BATCH = 8, SEQ = 4096, T = BATCH * SEQ, DM = 1024, DEPTH = 2;
constexpr int FH = 8, FD = 64, FW = 512;
constexpr int MH = 8, NOPE = 64, ROPE = 32, MDK = 96, MV = 64, MW = 512;
constexpr int QL = 256, KVL = 128;
constexpr int IN_W = 1960, IN_WP = 2048;
constexpr int NG = 8, EPG = 4, NE = 32, DE = 256;
constexpr int APAD = 73728;
constexpr float EPS = 1e-6f;
constexpr float LOG2E = 1.4426950408889634f;
constexpr float C2F = 0.125f * LOG2E;
constexpr float C2M = 0.10206207261596575f * LOG2E;
constexpr int RW = 48;

constexpr size_t MiB = 1u << 20;
constexpr size_t WS_CTL = 0;
constexpr size_t WS_WIN = 1 * MiB;
constexpr size_t WS_WUQ = 9 * MiB;
constexpr size_t WS_WUKV = 10 * MiB;
constexpr size_t WS_WR = 11 * MiB;
constexpr size_t WS_WO = 12 * MiB;
constexpr size_t WS_WGU = 16 * MiB;
constexpr size_t WS_WD = 80 * MiB;
constexpr size_t WS_ROPE = 112 * MiB;
constexpr size_t WS_SMALL = 116 * MiB;
constexpr size_t WS_HB = 124 * MiB;
constexpr size_t WS_X = 188 * MiB;
constexpr size_t WS_Z = 316 * MiB;
constexpr size_t WS_AO = 444 * MiB;
constexpr size_t WS_END = 508 * MiB;
constexpr size_t SM_RSTD = 0;
constexpr size_t SM_RSTD2 = 128 * 1024;
constexpr size_t SM_SSQQ = 256 * 1024;
constexpr size_t SM_SSQKV = 768 * 1024;
constexpr size_t SM_LF = 1280 * 1024;
constexpr size_t SM_D = 2304 * 1024;
constexpr size_t SM_GATE = 3328 * 1024;
constexpr size_t SM_LIST = 3584 * 1024;
constexpr size_t SM_TSLOT = 7680 * 1024;
constexpr size_t X_FQ = 0, X_FK = 32 * MiB, X_FV = 64 * MiB, X_CQ = 96 * MiB, X_CKV = 112 * MiB, X_KR = 120 * MiB;
constexpr size_t X_Y0 = 0, X_Y1 = 64 * MiB;
constexpr size_t X_YT = 0;
constexpr size_t Z_QM = 0, Z_KM = 48 * MiB, Z_KR = 80 * MiB, Z_VM = 96 * MiB;
constexpr size_t Z_HE = 0;
constexpr int CW_CNT = 8192;

__device__ __forceinline__ unsigned f2bf(float f) { unsigned u = __builtin_bit_cast(unsigned, f); return (u + 0x7fffu + ((u >> 16) & 1u)) >> 16; }
__device__ __forceinline__ float bf2f(unsigned h) { return __builtin_bit_cast(float, h << 16); }
__device__ __forceinline__ unsigned pk2(float lo, float hi) { return f2bf(lo) | (f2bf(hi) << 16); }
__device__ __forceinline__ float xadd32(float v) { const unsigned a = __builtin_bit_cast(unsigned, v); auto r = __builtin_amdgcn_permlane32_swap(a, a, false, false); const unsigned x = r[0], y = r[1]; return __builtin_bit_cast(float, x) + __builtin_bit_cast(float, y); }
__device__ __forceinline__ float xadd16(float v) { const unsigned a = __builtin_bit_cast(unsigned, v); auto r = __builtin_amdgcn_permlane16_swap(a, a, false, false); const unsigned x = r[0], y = r[1]; return __builtin_bit_cast(float, x) + __builtin_bit_cast(float, y); }
__device__ __forceinline__ float xchg32(float v, bool lower_half) { const unsigned a = __builtin_bit_cast(unsigned, v); auto r = __builtin_amdgcn_permlane32_swap(a, a, false, false); const unsigned x = r[0], y = r[1]; return __builtin_bit_cast(float, lower_half ? y : x); }
template <int CTRL> __device__ __forceinline__ float dppf(float v) { return __builtin_bit_cast(float, __builtin_amdgcn_update_dpp(0u, __builtin_bit_cast(unsigned, v), CTRL, 0xf, 0xf, true)); }
__device__ __forceinline__ float wave_sum(float v) {
    v += dppf<0xB1>(v); v += dppf<0x4E>(v); v += dppf<0x141>(v); v += dppf<0x140>(v);
    v = xadd16(v); v = xadd32(v);
    return v;
}
__device__ __forceinline__ float dot_bf16(const bf16_t* a, const bf16_t* b, int K) {
    float acc = 0.f;
    for (int k = 0; k < K; k += 8) {
        const u32x4 va = *(const u32x4*)(a + k), vb = *(const u32x4*)(b + k);
#pragma unroll
        for (int j = 0; j < 4; ++j) {
            acc += bf2f(va[j] & 0xffffu) * bf2f(vb[j] & 0xffffu);
            acc += bf2f(va[j] >> 16) * bf2f(vb[j] >> 16);
        }
    }
    return acc;
}

__device__ __forceinline__ int map_in(int n) {
    if (n < 1536) return n;
    if (n < 1792) return 1544 + (n - 1536);
    if (n < 1920) return 1800 + (n - 1792);
    if (n < 1952) return 1928 + (n - 1920);
    if (n < 1960) return 1536 + (n - 1952);
    return -1;
}
__device__ __forceinline__ int map_uq(int n) { return n < 512 ? (n >> 6) * 96 + (n & 63) : ((n - 512) >> 5) * 96 + 64 + ((n - 512) & 31); }
__device__ __forceinline__ int map_ukv(int n) { return n < 512 ? (n >> 6) * 128 + (n & 63) : ((n - 512) >> 6) * 128 + 64 + ((n - 512) & 63); }
__device__ __forceinline__ int map_id(int n) { return n; }

#define LAS __attribute__((address_space(3)))
#define GAS __attribute__((address_space(1)))
typedef short bf16x8 __attribute__((ext_vector_type(8)));
typedef float f32x2 __attribute__((ext_vector_type(2)));
typedef float f32x16 __attribute__((ext_vector_type(16)));
typedef unsigned u32x2 __attribute__((ext_vector_type(2)));
typedef int i32x4 __attribute__((ext_vector_type(4)));
typedef int i32x8 __attribute__((ext_vector_type(8)));
typedef long i64x2 __attribute__((ext_vector_type(2)));
constexpr size_t X_H8 = 96 * MiB;
constexpr float F8_WGU = 64.0f, F8_WD = 32.0f;
constexpr size_t Z_A8 = 48 * MiB;
constexpr size_t SM_WCS = 7936 * 1024;
__device__ __forceinline__ float xmx32(float v) { const unsigned a = __builtin_bit_cast(unsigned, v); auto r = __builtin_amdgcn_permlane32_swap(a, a, false, false); const unsigned x = r[0], y = r[1]; return fmaxf(__builtin_bit_cast(float, x), __builtin_bit_cast(float, y)); }
__device__ __forceinline__ float xmx16(float v) { const unsigned a = __builtin_bit_cast(unsigned, v); auto r = __builtin_amdgcn_permlane16_swap(a, a, false, false); const unsigned x = r[0], y = r[1]; return fmaxf(__builtin_bit_cast(float, x), __builtin_bit_cast(float, y)); }
__device__ __forceinline__ float wave_max0(float v) {
    v = fmaxf(v, dppf<0xB1>(v)); v = fmaxf(v, dppf<0x4E>(v)); v = fmaxf(v, dppf<0x141>(v)); v = fmaxf(v, dppf<0x140>(v)); v = xmx16(v); v = xmx32(v); return v; }
constexpr float AO_C = 6.0f;
constexpr size_t SM_WCS2 = SM_WCS + 16384;
__device__ __forceinline__ unsigned q4_i8c(float a, float b, float c, float d, float inv) {
    const int q0 = (int)__builtin_rintf(__builtin_amdgcn_fmed3f(a * inv, -127.f, 127.f)), q1 = (int)__builtin_rintf(__builtin_amdgcn_fmed3f(b * inv, -127.f, 127.f));
    const int q2 = (int)__builtin_rintf(__builtin_amdgcn_fmed3f(c * inv, -127.f, 127.f)), q3 = (int)__builtin_rintf(__builtin_amdgcn_fmed3f(d * inv, -127.f, 127.f));
    return ((unsigned)q0 & 0xffu) | (((unsigned)q1 & 0xffu) << 8) | (((unsigned)q2 & 0xffu) << 16) | ((unsigned)q3 << 24); }
__device__ __forceinline__ unsigned q4_i8(float a, float b, float c, float d, float inv) {
    const int q0 = (int)__builtin_rintf(a * inv), q1 = (int)__builtin_rintf(b * inv), q2 = (int)__builtin_rintf(c * inv), q3 = (int)__builtin_rintf(d * inv);
    return ((unsigned)q0 & 0xffu) | (((unsigned)q1 & 0xffu) << 8) | (((unsigned)q2 & 0xffu) << 16) | ((unsigned)q3 << 24); }
constexpr int NWAVES = 8;
constexpr int RING_BYTES = 131072;
constexpr int MISC_OFF = RING_BYTES + 320;
constexpr int TB_OFF = RING_BYTES + 1024;
constexpr int LDS_BYTES = 147456;

constexpr size_t X_QA = 120 * MiB, X_KA = 124 * MiB;
namespace pg8 {
constexpr int BM = 256, BK = 64, HALF = 128, HTB = HALF * BK * 2, NXCD = 8, WGM = 8;
__device__ __forceinline__ int lds_byte(int r, int c) { const int st = (r >> 4) * 2 + (c >> 5), rr = r & 15, cc = c & 31, ob = rr * 64 + cc * 2; return st * 1024 + (ob ^ (((ob >> 9) & 1) << 5)); }
__device__ __forceinline__ void stage_rc(int b, int& R, int& C) { const int st = b / 1024, sb = b % 1024, swz = sb ^ (((sb >> 9) & 1) << 5); R = (st >> 1) * 16 + swz / 64; C = (st & 1) * 32 + (swz % 64) / 2; }
__device__ __forceinline__ int perm32(int rho) { const int n = rho >> 4, i = rho & 15; return 8 * (i >> 2) + 4 * n + (i & 3); }
__device__ __forceinline__ unsigned cvt_pk_bf16(float lo, float hi) { unsigned r; asm volatile("v_cvt_pk_bf16_f32 %0, %1, %2" : "=v"(r) : "v"(lo), "v"(hi)); return r; }

struct Unit { int pm, pn, e, tile; const char* A; const char* B; };
struct LaneRC { int R[2], C[2]; };

struct DenseOrder {
    static constexpr bool GATHER = false;
    __device__ __forceinline__ void lane_offs(const Unit&, const LaneRC&, unsigned (&)[2], unsigned (&)[2]) const {}
    const char* A; const char* Bt; int K, nM, nN, nwg, G, c, rot;
    __device__ __forceinline__ void init(const void* A_, const void* Bt_, int M, int N, int K_, int G_, int c_) { A = (const char*)A_; Bt = (const char*)Bt_; K = K_; nM = M / BM; nN = N / BM; nwg = nM * nN; G = G_; c = c_; rot = 0; }
    __device__ __forceinline__ bool next(int i, Unit& u) const {
        const long L = (long)i * G + c; if (L >= nwg) return false;
        int wgid = (int)L; { const int q = nwg / NXCD, r = nwg % NXCD, xcd = wgid % NXCD, off = wgid / NXCD; wgid = (xcd < r ? xcd * (q + 1) : r * (q + 1) + (xcd - r) * q) + off; }
        const int nig = WGM * nN, gid = wgid / nig, fm = gid * WGM, gsz = (nM - fm) < WGM ? (nM - fm) : WGM;
        u.pm = fm + ((wgid % nig) % gsz); u.pn = (wgid % nig) / gsz; u.e = 0; u.tile = 0;
        if (rot != 0 && (i & 2)) u.pn = (u.pn + rot) % nN;
        u.A = A + (size_t)u.pm * BM * K * 2; u.B = Bt + (size_t)u.pn * BM * K * 2;
        return true;
    }
};

template <class Epi, class Sched>
__device__ __forceinline__ void gemm_phase(LAS unsigned char* lds, const int wave_in, const int K_in, const Sched& S, const Epi& E, const int gabl = 0) {
    int K_ = K_in; asm volatile("" : "+s"(K_)); const int K = K_;
    int wave_o = wave_in; asm volatile("" : "+s"(wave_o));
    int tid_; asm volatile("v_mbcnt_lo_u32_b32 %0, -1, 0\n\tv_mbcnt_hi_u32_b32 %0, -1, %0" : "=v"(tid_)); tid_ += 64 * wave_o;
    const int tid = tid_, wid = wave_o, lane = tid & 63, wr = wid >> 2, wc = wid & 3, fr = lane & 15, fq = lane >> 4;
    const int nt = K / BK;
    LaneRC rc; unsigned voffA[2], voffB[2]; constexpr bool GA = Sched::GATHER;
#pragma unroll
    for (int i = 0; i < 2; ++i) { int R, C; stage_rc(tid * 16 + i * 8192, R, C); rc.R[i] = R; rc.C[i] = C; const int Rb = Epi::PERM ? ((R & ~31) + perm32(R & 31)) : R; voffA[i] = (unsigned)(R * K + C) * 2u; voffB[i] = (unsigned)(Rb * K + C) * 2u; }
    const size_t kstep = (size_t)(BK * 2);
    const size_t hstep = (size_t)HALF * K * 2;
    const unsigned ldsw = (unsigned)wid * 1024u;
    const int aoff = lds_byte(wr * 64 + fr, fq * 8), boff = lds_byte(wc * 32 + fr, fq * 8);
#define PG8_SA(b, h) (((b) * 2 + (h)) * HTB)
#define PG8_SB(b, h) ((4 + (b) * 2 + (h)) * HTB)
#define PG8_STAGE(bufoff, gbase, voff) do { _Pragma("unroll") for (int _i = 0; _i < 2; ++_i) \
        __builtin_amdgcn_global_load_lds((const unsigned*)((const char*)(gbase) + (voff)[_i]), (LAS unsigned*)(lds + (bufoff) + ldsw + _i * 8192), 16, 0, 0); } while (0)
#define PG8_LDA(dst, b, h) do { _Pragma("unroll") for (int m = 0; m < 4; ++m) _Pragma("unroll") for (int k = 0; k < 2; ++k) dst[m][k] = *(const LAS bf16x8*)(lds + PG8_SA(b, h) + aoff + m * 2048 + k * 1024); } while (0)
#define PG8_LDB(dst, b, h) do { _Pragma("unroll") for (int n = 0; n < 2; ++n) _Pragma("unroll") for (int k = 0; k < 2; ++k) dst[n][k] = *(const LAS bf16x8*)(lds + PG8_SB(b, h) + boff + n * 2048 + k * 1024); } while (0)
    unsigned f8one = 0x7f7f7f7fu; asm volatile("" : "+v"(f8one));
#define PG8_MMA(ai, bj, At, Bt) do { if (gabl == 2) { asm volatile("" :: "v"(At[0][0]), "v"(At[3][1]), "v"(Bt[0][0]), "v"(Bt[1][1])); break; } __builtin_amdgcn_s_setprio(1); \
        if constexpr (Epi::F8) { _Pragma("unroll") for (int m = 0; m < 4; ++m) _Pragma("unroll") for (int n = 0; n < 2; ++n) { \
            const i32x8 b_ = __builtin_shufflevector(__builtin_bit_cast(i32x4, Bt[n][0]), __builtin_bit_cast(i32x4, Bt[n][1]), 0, 1, 2, 3, 4, 5, 6, 7); \
            const i32x8 a_ = __builtin_shufflevector(__builtin_bit_cast(i32x4, At[m][0]), __builtin_bit_cast(i32x4, At[m][1]), 0, 1, 2, 3, 4, 5, 6, 7); \
            asm volatile("v_mfma_scale_f32_16x16x128_f8f6f4 %0, %1, %2, %0, %3, %3 op_sel_hi:[0,0,0]" : "+v"(acc[ai][bj][m][n]) : "v"(b_), "v"(a_), "v"(f8one)); } } \
        else if constexpr (Epi::I8) { _Pragma("unroll") for (int m = 0; m < 4; ++m) _Pragma("unroll") for (int n = 0; n < 2; ++n) _Pragma("unroll") for (int k = 0; k < 2; ++k) \
        acc[ai][bj][m][n] = __builtin_bit_cast(f32x4, __builtin_amdgcn_mfma_i32_16x16x64_i8(__builtin_bit_cast(i32x4, Bt[n][k]), __builtin_bit_cast(i32x4, At[m][k]), __builtin_bit_cast(i32x4, acc[ai][bj][m][n]), 0, 0, 0)); } \
        else { _Pragma("unroll") for (int m = 0; m < 4; ++m) _Pragma("unroll") for (int n = 0; n < 2; ++n) _Pragma("unroll") for (int k = 0; k < 2; ++k) \
        acc[ai][bj][m][n] = __builtin_amdgcn_mfma_f32_16x16x32_bf16(Bt[n][k], At[m][k], acc[ai][bj][m][n], 0, 0, 0); } __builtin_amdgcn_s_setprio(0); } while (0)
#define PG8_WAIT_V(n) asm volatile("s_waitcnt vmcnt(" #n ")" ::: "memory")
#define PG8_WAIT_L(n) asm volatile("s_waitcnt lgkmcnt(" #n ")" ::: "memory")
#define PG8_BAR __builtin_amdgcn_s_barrier()
#define PG8_SCHED __builtin_amdgcn_sched_barrier(0)
#define PG8_STAGE_A(bufoff, base, h, V0, V1) do { if constexpr (GA) { if (h) PG8_STAGE(bufoff, base, V1); else PG8_STAGE(bufoff, base, V0); } else { PG8_STAGE(bufoff, (base) + ((h) ? hstep : 0), voffA); } } while (0)
    Unit cur, nxt; int ui = 0;
    unsigned cv0[2] = {0u, 0u}, cv1[2] = {0u, 0u}, nv0[2] = {0u, 0u}, nv1[2] = {0u, 0u};
    if (!S.next(0, cur)) return;
    S.lane_offs(cur, rc, cv0, cv1);
    f32x4 acc[2][2][4][2];
#pragma unroll
    for (int a = 0; a < 2; ++a)
#pragma unroll
        for (int b = 0; b < 2; ++b)
#pragma unroll
            for (int m = 0; m < 4; ++m)
#pragma unroll
                for (int n = 0; n < 2; ++n) acc[a][b][m][n] = (f32x4){0.f, 0.f, 0.f, 0.f};
    bf16x8 At[4][2], B0[2][2], B1[2][2];
    const char* cA = cur.A; const char* cB = cur.B;
    PG8_STAGE(PG8_SB(0, 0), cB, voffB); PG8_STAGE(PG8_SB(0, 1), cB + hstep, voffB); PG8_STAGE_A(PG8_SA(0, 0), cA, 0, cv0, cv1); PG8_STAGE_A(PG8_SA(0, 1), cA, 1, cv0, cv1);
    if (wr == 1) PG8_BAR;
    PG8_WAIT_V(2); PG8_BAR;
    PG8_STAGE(PG8_SB(1, 0), cB + kstep, voffB); PG8_STAGE_A(PG8_SA(1, 0), cA + kstep, 0, cv0, cv1); PG8_STAGE(PG8_SB(1, 1), cB + hstep + kstep, voffB);
    PG8_WAIT_V(6); PG8_BAR;
    for (;;) {
        const bool has_next = S.next(ui + 1, nxt);
        if (!has_next) nxt = cur;
        if constexpr (GA) { if (has_next) S.lane_offs(nxt, rc, nv0, nv1); else { nv0[0] = cv0[0]; nv0[1] = cv0[1]; nv1[0] = cv1[0]; nv1[1] = cv1[1]; } }
        const char* nA = nxt.A; const char* nB = nxt.B;
#pragma unroll 1
        for (int t = 0; t < nt; t += 2) {
            const bool last = (t == nt - 2);
            const char* a1 = cA + (size_t)(t + 1) * kstep;
            const char* a2 = last ? nA : cA + (size_t)(t + 2) * kstep; const char* b2 = last ? nB : cB + (size_t)(t + 2) * kstep;
            const char* a3 = a2 + kstep; const char* b3 = b2 + kstep;
            unsigned x0[2], x1[2];
#pragma unroll
            for (int i = 0; i < 2; ++i) { x0[i] = last ? nv0[i] : cv0[i]; x1[i] = last ? nv1[i] : cv1[i]; }
            PG8_LDB(B0, 0, 0); PG8_LDB(B1, 0, 1); PG8_SCHED; PG8_LDA(At, 0, 0); PG8_STAGE_A(PG8_SA(1, 1), a1, 1, cv0, cv1);
            PG8_WAIT_V(8); PG8_WAIT_L(0); PG8_BAR; PG8_MMA(0, 0, At, B0); PG8_MMA(0, 1, At, B1); PG8_BAR; PG8_SCHED;
            PG8_LDA(At, 0, 1); PG8_STAGE(PG8_SB(0, 0), b2, voffB); PG8_STAGE(PG8_SB(0, 1), b2 + hstep, voffB); PG8_STAGE_A(PG8_SA(0, 0), a2, 0, x0, x1);
            PG8_WAIT_V(8); PG8_WAIT_L(0); PG8_BAR; PG8_MMA(1, 0, At, B0); PG8_MMA(1, 1, At, B1); PG8_BAR; PG8_SCHED;
            PG8_LDB(B0, 1, 0); PG8_LDB(B1, 1, 1); PG8_SCHED; PG8_LDA(At, 1, 0); PG8_STAGE_A(PG8_SA(0, 1), a2, 1, x0, x1);
            PG8_WAIT_V(8); PG8_WAIT_L(0); PG8_BAR; PG8_MMA(0, 0, At, B0); PG8_MMA(0, 1, At, B1); PG8_BAR; PG8_SCHED;
            PG8_LDA(At, 1, 1); PG8_STAGE(PG8_SB(1, 0), b3, voffB); PG8_STAGE(PG8_SB(1, 1), b3 + hstep, voffB); PG8_STAGE_A(PG8_SA(1, 0), a3, 0, x0, x1);
            PG8_WAIT_V(8); PG8_WAIT_L(0); PG8_BAR; PG8_MMA(1, 0, At, B0); PG8_MMA(1, 1, At, B1); PG8_BAR; PG8_SCHED;
        }
        if (wr == 0) PG8_BAR;
        if (gabl != 0) { _Pragma("unroll") for (int a = 0; a < 2; ++a) _Pragma("unroll") for (int b = 0; b < 2; ++b) _Pragma("unroll") for (int m = 0; m < 4; ++m) _Pragma("unroll") for (int n = 0; n < 2; ++n) asm volatile("" :: "v"(acc[a][b][m][n])); }
        else { if constexpr (Epi::F8) asm volatile("s_nop 15\n\ts_nop 15\n\ts_nop 15" ::: "memory");
          int fr_e = fr, fq_e = fq; asm volatile("" : "+v"(fr_e), "+v"(fq_e));
          E(acc, cur, wr, wc, fr_e, fq_e); }
        if (!has_next) break;
#pragma unroll
        for (int a = 0; a < 2; ++a)
#pragma unroll
            for (int b = 0; b < 2; ++b)
#pragma unroll
                for (int m = 0; m < 4; ++m)
#pragma unroll
                    for (int n = 0; n < 2; ++n) acc[a][b][m][n] = (f32x4){0.f, 0.f, 0.f, 0.f};
        cur = nxt; cA = nA; cB = nB; ++ui;
        if constexpr (GA) { cv0[0] = nv0[0]; cv0[1] = nv0[1]; cv1[0] = nv1[0]; cv1[1] = nv1[1]; }
        if (wr == 1) PG8_BAR;
    }
    PG8_WAIT_V(0);
    PG8_BAR;
#undef PG8_SA
#undef PG8_SB
#undef PG8_STAGE
#undef PG8_STAGE_A
#undef PG8_LDA
#undef PG8_LDB
#undef PG8_MMA
#undef PG8_WAIT_V
#undef PG8_WAIT_L
#undef PG8_BAR
#undef PG8_SCHED
}
}

struct MkArgs {
    const float* x; const int* pos; const float* b_f; const float* final_norm; const float* in[19];
    float* H; unsigned char* ws;
    int ph_lo, ph_hi;
};
#define WSA(type, off) ((type*)(ws + (off)))

typedef f32x4 Acc[2][2][4][2];
__device__ __forceinline__ u32x4 pack8(const f32x4 a, const f32x4 b, float s) {
    u32x4 w; w.x = pg8::cvt_pk_bf16(a[0] * s, a[1] * s); w.y = pg8::cvt_pk_bf16(a[2] * s, a[3] * s); w.z = pg8::cvt_pk_bf16(b[0] * s, b[1] * s); w.w = pg8::cvt_pk_bf16(b[2] * s, b[3] * s); return w;
}
__device__ __forceinline__ float sq8(const f32x4 a, const f32x4 b) { return (a[0] * a[0] + a[1] * a[1]) + (a[2] * a[2] + a[3] * a[3]) + (b[0] * b[0] + b[1] * b[1]) + (b[2] * b[2] + b[3] * b[3]); }
__device__ __forceinline__ void rotary8(f32x4& v0, f32x4& v1, const float2* cs8, int fq) {
    f32x4 p0, p1;
#pragma unroll
    for (int j = 0; j < 4; ++j) { p0[j] = xchg32(v0[j], fq < 2); p1[j] = xchg32(v1[j], fq < 2); }
    const float sg = fq < 2 ? -1.f : 1.f;
#pragma unroll
    for (int j = 0; j < 4; ++j) { const float2 c0 = cs8[j], c1 = cs8[4 + j]; v0[j] = v0[j] * c0.x + sg * p0[j] * c0.y; v1[j] = v1[j] * c1.x + sg * p1[j] * c1.y; }
}

__device__ __forceinline__ void ld8_rows_f32x4(f32x4 (&v)[8], const float* p) {
    asm volatile("global_load_dwordx4 %0, %8, off\n\tglobal_load_dwordx4 %1, %8, off offset:256\n\tglobal_load_dwordx4 %2, %8, off offset:512\n\tglobal_load_dwordx4 %3, %8, off offset:768\n\t"
                 "global_load_dwordx4 %4, %8, off offset:2048\n\tglobal_load_dwordx4 %5, %8, off offset:2304\n\tglobal_load_dwordx4 %6, %8, off offset:2560\n\tglobal_load_dwordx4 %7, %8, off offset:2816\n\ts_waitcnt vmcnt(0)"
                 : "=&v"(v[0]), "=&v"(v[1]), "=&v"(v[2]), "=&v"(v[3]), "=&v"(v[4]), "=&v"(v[5]), "=&v"(v[6]), "=&v"(v[7]) : "v"(p) : "memory");
}

struct EpiInProj {
    static constexpr bool PERM = true; static constexpr bool F8 = false; static constexpr bool I8 = true;
    unsigned char* ws; const float* b_f; const float* wcs;
    __device__ __forceinline__ void operator()(Acc& acc, const pg8::Unit& u, int wr, int wc, int fr, int fq) const {
        const int row0 = u.pm * 256 + wr * 64 + fr, pn = u.pn;
        { const float* cp = wcs + pn * 256 + wc * 32 + 8 * fq;
          const f32x4 c00 = *(const f32x4*)(cp), c01 = *(const f32x4*)(cp + 4), c10 = *(const f32x4*)(cp + 128), c11 = *(const f32x4*)(cp + 132);
#pragma unroll
          for (int ai = 0; ai < 2; ++ai)
#pragma unroll
              for (int m = 0; m < 4; ++m) {
                  acc[ai][0][m][0] = __builtin_convertvector(__builtin_bit_cast(i32x4, acc[ai][0][m][0]), f32x4) * c00; acc[ai][0][m][1] = __builtin_convertvector(__builtin_bit_cast(i32x4, acc[ai][0][m][1]), f32x4) * c01;
                  acc[ai][1][m][0] = __builtin_convertvector(__builtin_bit_cast(i32x4, acc[ai][1][m][0]), f32x4) * c10; acc[ai][1][m][1] = __builtin_convertvector(__builtin_bit_cast(i32x4, acc[ai][1][m][1]), f32x4) * c11; } }
        const float* rstd = WSA(float, WS_SMALL + SM_RSTD);
        float rsv[8];
#pragma unroll
        for (int i = 0; i < 8; ++i) rsv[i] = rstd[row0 + (i >> 2) * 128 + (i & 3) * 16];
        if (pn < 6) {
            bf16_t* base0 = WSA(bf16_t, WS_X + (size_t)(pn >> 1) * 32 * MiB) + (pn & 1) * 256 + wc * 32 + 8 * fq;
            float nmx0 = 0.f, nmx1 = 0.f;
#pragma unroll
            for (int ai = 0; ai < 2; ++ai)
#pragma unroll
                for (int m = 0; m < 4; ++m) {
                    const int row = row0 + ai * 128 + m * 16; const float sc = pn < 2 ? rsv[ai * 4 + m] * C2F : rsv[ai * 4 + m];
                    bf16_t* base = base0 + (size_t)row * 512;
                    *(u32x4*)(base) = pack8(acc[ai][0][m][0], acc[ai][0][m][1], sc); *(u32x4*)(base + 128) = pack8(acc[ai][1][m][0], acc[ai][1][m][1], sc);
                    if (pn < 4) { float s0 = sq8(acc[ai][0][m][0], acc[ai][0][m][1]) * sc * sc, s1 = sq8(acc[ai][1][m][0], acc[ai][1][m][1]) * sc * sc;
                        s0 = xadd16(s0); s0 = xadd32(s0); s1 = xadd16(s1); s1 = xadd32(s1); nmx0 = fmaxf(nmx0, s0); nmx1 = fmaxf(nmx1, s1); }
                }
            if (pn < 4) {
                nmx0 = fmaxf(nmx0, dppf<0xB1>(nmx0)); nmx0 = fmaxf(nmx0, dppf<0x4E>(nmx0)); nmx0 = fmaxf(nmx0, dppf<0x141>(nmx0)); nmx0 = fmaxf(nmx0, dppf<0x140>(nmx0));
                nmx1 = fmaxf(nmx1, dppf<0xB1>(nmx1)); nmx1 = fmaxf(nmx1, dppf<0x4E>(nmx1)); nmx1 = fmaxf(nmx1, dppf<0x141>(nmx1)); nmx1 = fmaxf(nmx1, dppf<0x140>(nmx1));
                if (fq == 0 && fr == 0) { float* tm = WSA(float, WS_SMALL + SM_D + 65536) + ((((size_t)(pn >> 1) * 128 + u.pm) * 8 + (pn & 1) * 4 + (wc >> 1)) * 2 + (wc & 1)) * 2 + wr;
                    tm[0] = nmx0; tm[8] = nmx1; }
            }
        } else if (pn == 6) {
#pragma unroll
            for (int ai = 0; ai < 2; ++ai)
#pragma unroll
                for (int m = 0; m < 4; ++m) {
                    const int row = row0 + ai * 128 + m * 16; const float rs = rsv[ai * 4 + m];
                    bf16_t* base = WSA(bf16_t, WS_X + X_CQ) + (size_t)row * QL + wc * 32 + 8 * fq;
                    *(u32x4*)(base) = pack8(acc[ai][0][m][0], acc[ai][0][m][1], rs); *(u32x4*)(base + 128) = pack8(acc[ai][1][m][0], acc[ai][1][m][1], rs);
                    float s = (sq8(acc[ai][0][m][0], acc[ai][0][m][1]) + sq8(acc[ai][1][m][0], acc[ai][1][m][1])) * rs * rs; s = xadd16(s); s = xadd32(s);
                    if (fq == 0) WSA(float, WS_SMALL + SM_SSQQ)[row * 4 + wc] = s;
                }
        } else {
            f32x4 lfs0 = {0.f, 0.f, 0.f, 0.f}, lfs1 = lfs0;
#pragma unroll
            for (int ai = 0; ai < 2; ++ai)
#pragma unroll
                for (int m = 0; m < 4; ++m) {
                    const int row = row0 + ai * 128 + m * 16; const float rs = rsv[ai * 4 + m];
                    *(u32x4*)(WSA(bf16_t, WS_X + X_CKV) + (size_t)row * KVL + wc * 32 + 8 * fq) = pack8(acc[ai][0][m][0], acc[ai][0][m][1], rs);
                    float s = sq8(acc[ai][0][m][0], acc[ai][0][m][1]) * rs * rs; s = xadd16(s); s = xadd32(s);
                    if (fq == 0) WSA(float, WS_SMALL + SM_SSQKV)[row * 4 + wc] = s;
                    if (wc == 0) {
                        f32x4 v0 = acc[ai][1][m][0] * rs, v1 = acc[ai][1][m][1] * rs;
                        float2 cs8[8]; const float2* cp = WSA(float2, WS_ROPE) + (size_t)row * 16 + 8 * (fq & 1);
#pragma unroll
                        for (int j = 0; j < 8; ++j) cs8[j] = cp[j];
                        rotary8(v0, v1, cs8, fq);
                        const u32x4 w = pack8(v0, v1, 1.f);
                        *(u32x4*)(WSA(bf16_t, WS_Z + Z_KR) + (size_t)row * ROPE + 8 * fq) = w;
                    } else if (wc == 1 && fq == 0) {
                        f32x4 o[2];
#pragma unroll
                        for (int n = 0; n < 2; ++n)
#pragma unroll
                            for (int j = 0; j < 4; ++j) { const float z = acc[ai][1][m][n][j] * rs + b_f[4 * n + j];
                                o[n][j] = fminf(z, 0.f) - 0.6931471805599453f * __builtin_amdgcn_logf(1.0f + __builtin_amdgcn_exp2f(-1.4426950408889634f * fabsf(z))); }
                        f32x4* lf = (f32x4*)(WSA(float, WS_SMALL + SM_LF) + (size_t)row * 8); lf[0] = o[0]; lf[1] = o[1];
                        lfs0 += o[0]; lfs1 += o[1];
                    }
                }
            if (wc == 1) {
#pragma unroll
                for (int j = 0; j < 4; ++j) { float a = lfs0[j], bq = lfs1[j];
                    a += dppf<0xB1>(a); a += dppf<0x4E>(a); a += dppf<0x141>(a); a += dppf<0x140>(a);
                    bq += dppf<0xB1>(bq); bq += dppf<0x4E>(bq); bq += dppf<0x141>(bq); bq += dppf<0x140>(bq);
                    lfs0[j] = a; lfs1[j] = bq; }
                if (fq == 0 && fr == 0) { f32x4* ts = (f32x4*)(WSA(float, WS_SMALL + SM_D) + ((size_t)u.pm * 2 + wr) * 8); ts[0] = lfs0; ts[1] = lfs1; }
            }
        }
    }
};
struct EpiUpQ {
    static constexpr bool PERM = true; static constexpr bool F8 = false; static constexpr bool I8 = false;
    unsigned char* ws;
    __device__ __forceinline__ void operator()(const Acc& acc, const pg8::Unit& u, int wr, int wc, int fr, int fq) const {
        const int row0 = u.pm * 256 + wr * 64 + fr, pn = u.pn;
        float rsv[8];
#pragma unroll
        for (int i = 0; i < 8; ++i) rsv[i] = 0.f;
        { f32x4 sp[8]; ld8_rows_f32x4(sp, WSA(float, WS_SMALL + SM_SSQQ) + (size_t)row0 * 4);
#pragma unroll
          for (int i = 0; i < 8; ++i) rsv[i] = ((sp[i][0] + sp[i][1]) + (sp[i][2] + sp[i][3])) * (1.0f / QL) + EPS; }
        if (pn < 2) {
            const int c0 = pn * 256 + wc * 32 + 8 * fq, c1 = c0 + 128;
            bf16_t* q0 = WSA(bf16_t, WS_Z + Z_QM) + (c0 >> 6) * MDK + (c0 & 63); bf16_t* q1 = WSA(bf16_t, WS_Z + Z_QM) + (c1 >> 6) * MDK + (c1 & 63);
#pragma unroll
            for (int ai = 0; ai < 2; ++ai)
#pragma unroll
                for (int m = 0; m < 4; ++m) { const size_t ro = (size_t)(row0 + ai * 128 + m * 16) * (MH * MDK); const float sc = C2M / sqrtf(rsv[ai * 4 + m]);
                    *(u32x4*)(q0 + ro) = pack8(acc[ai][0][m][0], acc[ai][0][m][1], sc); *(u32x4*)(q1 + ro) = pack8(acc[ai][1][m][0], acc[ai][1][m][1], sc); }
        } else {
#pragma unroll
            for (int ai = 0; ai < 2; ++ai)
#pragma unroll
                for (int m = 0; m < 4; ++m) {
                    asm volatile("" ::: "memory");
                    const int row = row0 + ai * 128 + m * 16; const float rs = 1.0f / sqrtf(rsv[ai * 4 + m]);
                    bf16_t* qm = WSA(bf16_t, WS_Z + Z_QM) + (size_t)row * (MH * MDK);
                    float2 cs8[8]; const float2* cp = WSA(float2, WS_ROPE) + (size_t)row * 16 + 8 * (fq & 1);
#pragma unroll
                    for (int j = 0; j < 8; ++j) cs8[j] = cp[j];
#pragma unroll
                    for (int bj = 0; bj < 2; ++bj) { f32x4 v0 = acc[ai][bj][m][0] * rs, v1 = acc[ai][bj][m][1] * rs;
                        rotary8(v0, v1, cs8, fq);
                        *(u32x4*)(qm + (4 * bj + wc) * MDK + NOPE + 8 * fq) = pack8(v0, v1, C2M); }
                }
        }
    }
};
struct EpiUpKV {
    static constexpr bool PERM = true; static constexpr bool F8 = false; static constexpr bool I8 = false;
    unsigned char* ws;
    __device__ __forceinline__ void operator()(const Acc& acc, const pg8::Unit& u, int wr, int wc, int fr, int fq) const {
        const int row0 = u.pm * 256 + wr * 64 + fr, pn = u.pn;
        float rsv[8];
#pragma unroll
        for (int i = 0; i < 8; ++i) rsv[i] = 0.f;
        { f32x4 sp[8]; ld8_rows_f32x4(sp, WSA(float, WS_SMALL + SM_SSQKV) + (size_t)row0 * 4);
#pragma unroll
          for (int i = 0; i < 8; ++i) rsv[i] = ((sp[i][0] + sp[i][1]) + (sp[i][2] + sp[i][3])) * (1.0f / KVL) + EPS; }
#pragma unroll
        for (int ai = 0; ai < 2; ++ai)
#pragma unroll
            for (int m = 0; m < 4; ++m) {
                asm volatile("" ::: "memory");
                const int row = row0 + ai * 128 + m * 16;
                const float rs = 1.0f / sqrtf(rsv[ai * 4 + m]);
#pragma unroll
                for (int bj = 0; bj < 2; ++bj) { const int c = (pn & 1) * 256 + bj * 128 + wc * 32 + 8 * fq;
                    bf16_t* dst = (pn < 2 ? WSA(bf16_t, WS_Z + Z_KM) : WSA(bf16_t, WS_Z + Z_VM)) + (size_t)row * MW + c;
                    *(u32x4*)dst = pack8(acc[ai][bj][m][0], acc[ai][bj][m][1], rs); }
            }
    }
};
struct EpiWo {
    static constexpr bool PERM = true; static constexpr bool F8 = false; static constexpr bool I8 = true;
    unsigned char* ws; const float* xsrc; const float* wcs;
    __device__ __forceinline__ void operator()(Acc& acc, const pg8::Unit& u, int wr, int wc, int fr, int fq) const {
        const int row0 = u.pm * 256 + wr * 64 + fr;
        { const float* cp = wcs + u.pn * 256 + wc * 32 + 8 * fq;
          const f32x4 c00 = *(const f32x4*)(cp) * (AO_C / 127.0f), c01 = *(const f32x4*)(cp + 4) * (AO_C / 127.0f), c10 = *(const f32x4*)(cp + 128) * (AO_C / 127.0f), c11 = *(const f32x4*)(cp + 132) * (AO_C / 127.0f);
#pragma unroll
          for (int ai = 0; ai < 2; ++ai)
#pragma unroll
              for (int m = 0; m < 4; ++m) {
                  acc[ai][0][m][0] = __builtin_convertvector(__builtin_bit_cast(i32x4, acc[ai][0][m][0]), f32x4) * c00; acc[ai][0][m][1] = __builtin_convertvector(__builtin_bit_cast(i32x4, acc[ai][0][m][1]), f32x4) * c01;
                  acc[ai][1][m][0] = __builtin_convertvector(__builtin_bit_cast(i32x4, acc[ai][1][m][0]), f32x4) * c10; acc[ai][1][m][1] = __builtin_convertvector(__builtin_bit_cast(i32x4, acc[ai][1][m][1]), f32x4) * c11; } }
#pragma unroll
        for (int ai = 0; ai < 2; ++ai)
#pragma unroll
            for (int m = 0; m < 4; ++m) {
                asm volatile("" ::: "memory");
                const int row = row0 + ai * 128 + m * 16;
#pragma unroll
                for (int bj = 0; bj < 2; ++bj) { const size_t off = (size_t)row * DM + u.pn * 256 + bj * 128 + wc * 32 + 8 * fq;
                    f32x4 h0, h1;
                    if (xsrc) { h0 = *(const f32x4*)(xsrc + off); h1 = *(const f32x4*)(xsrc + off + 4); }
                    else { const u32x4 hv = *(const u32x4*)(WSA(bf16_t, WS_HB) + off);
                        h0 = (f32x4){bf2f(hv.x & 0xffffu), bf2f(hv.x >> 16), bf2f(hv.y & 0xffffu), bf2f(hv.y >> 16)}; h1 = (f32x4){bf2f(hv.z & 0xffffu), bf2f(hv.z >> 16), bf2f(hv.w & 0xffffu), bf2f(hv.w >> 16)}; }
                    h0 += acc[ai][bj][m][0]; h1 += acc[ai][bj][m][1];
                    *(u32x4*)(WSA(bf16_t, WS_HB) + off) = pack8(h0, h1, 1.f);
                    { int w0 = __builtin_amdgcn_cvt_pk_fp8_f32(h0[0], h0[1], 0, false); w0 = __builtin_amdgcn_cvt_pk_fp8_f32(h0[2], h0[3], w0, true);
                      int w1 = __builtin_amdgcn_cvt_pk_fp8_f32(h1[0], h1[1], 0, false); w1 = __builtin_amdgcn_cvt_pk_fp8_f32(h1[2], h1[3], w1, true);
                      *(u32x2*)(ws + WS_X + X_H8 + off) = (u32x2){(unsigned)w0, (unsigned)w1}; } }
            }
    }
};

__device__ __forceinline__ void moe_build_tb(LAS unsigned char* lds, const unsigned* cnt, int wave, int lane) {
    if (wave == 0) {
        const int c = lane < NE ? (int)__hip_atomic_load(cnt + (lane & 31) * 64, __ATOMIC_RELAXED, __HIP_MEMORY_SCOPE_AGENT) : 0;
        const int nt = (c + 255) >> 8; int pre = nt;
#pragma unroll
        for (int o = 1; o < 64; o <<= 1) { const int v = __builtin_amdgcn_ds_bpermute((lane - o) << 2, pre); if (lane >= o) pre += v; }
        LAS int* tb = (LAS int*)(lds + TB_OFF);
        if (lane < NE) { tb[lane + 1] = pre; tb[40 + lane] = c; }
        if (lane == 0) tb[0] = 0;
    }
    asm volatile("s_waitcnt lgkmcnt(0)" ::: "memory"); __syncthreads();
}
template <int NPN, bool GATHER_>
struct MoeOrder {
    static constexpr bool GATHER = GATHER_;
    LAS const int* tb; const char* A; const char* Bt; const unsigned* list; int K, G, c; size_t bstride;
    __device__ __forceinline__ bool next(int i, pg8::Unit& u) const {
        const int L = i * G + c, total = tb[NE] * NPN; if (L >= total) return false;
        const int g = L / NPN, pn = L % NPN; int e = 0;
        for (int j = 1; j < NE; ++j) e = (tb[j] <= g) ? j : e;
        u.pm = g; u.pn = pn; u.e = e; u.tile = g - tb[e];
        u.A = GATHER_ ? A : A + (size_t)g * 256 * K * 2;
        u.B = Bt + (size_t)e * bstride + (size_t)pn * 256 * K * 2;
        return true;
    }
    __device__ __forceinline__ void lane_offs(const pg8::Unit& u, const pg8::LaneRC& rc, unsigned (&v0)[2], unsigned (&v1)[2]) const {
        if constexpr (GATHER_) {
            const int cn = tb[40 + u.e]; const unsigned* le = list + (size_t)u.e * T;
#pragma unroll
            for (int i = 0; i < 2; ++i) {
                const int p0 = u.tile * 256 + rc.R[i], p1 = p0 + 128;
                const unsigned t0 = le[p0 < cn ? p0 : 0] >> 1, t1 = le[p1 < cn ? p1 : 0] >> 1;
                v0[i] = (t0 * (unsigned)K + (unsigned)rc.C[i]) * 2u; v1[i] = (t1 * (unsigned)K + (unsigned)rc.C[i]) * 2u;
            }
        }
    }
};
struct EpiGU {
    static constexpr bool PERM = true; static constexpr bool F8 = true; static constexpr bool I8 = false;
    unsigned char* ws; LAS const int* tb;
    __device__ __forceinline__ void operator()(const Acc& acc, const pg8::Unit& u, int wr, int wc, int fr, int fq) const {
        const int cn = tb[40 + u.e]; const unsigned* le = WSA(unsigned, WS_SMALL + SM_LIST) + (size_t)u.e * T;
        unsigned tokv[8]; float rsv[8];
#pragma unroll
        for (int i = 0; i < 8; ++i) { const int pos = u.tile * 256 + (i >> 2) * 128 + wr * 64 + (i & 3) * 16 + fr; tokv[i] = le[pos < cn ? pos : 0] >> 1; }
#pragma unroll
        for (int i = 0; i < 8; ++i) rsv[i] = WSA(float, WS_SMALL + SM_RSTD2)[tokv[i]];
        unsigned char* he = ws + WS_Z + Z_HE + ((size_t)u.pm * 256 + wr * 64 + fr) * DE + u.pn * 128 + wc * 32 + 8 * fq;
#pragma unroll
        for (int ai = 0; ai < 2; ++ai)
#pragma unroll
            for (int m = 0; m < 4; ++m) { const float rs = rsv[ai * 4 + m] * (1.0f / F8_WGU);
                f32x4 h0, h1;
#pragma unroll
                for (int j = 0; j < 4; ++j) {
                    const float g0 = acc[ai][0][m][0][j] * rs, u0 = acc[ai][1][m][0][j] * rs, g1 = acc[ai][0][m][1][j] * rs, u1 = acc[ai][1][m][1][j] * rs;
                    h0[j] = g0 * __builtin_amdgcn_rcpf(1.0f + __expf(-g0)) * u0; h1[j] = g1 * __builtin_amdgcn_rcpf(1.0f + __expf(-g1)) * u1;
                }
                int w0 = __builtin_amdgcn_cvt_pk_fp8_f32(h0[0], h0[1], 0, false); w0 = __builtin_amdgcn_cvt_pk_fp8_f32(h0[2], h0[3], w0, true);
                int w1 = __builtin_amdgcn_cvt_pk_fp8_f32(h1[0], h1[1], 0, false); w1 = __builtin_amdgcn_cvt_pk_fp8_f32(h1[2], h1[3], w1, true);
                *(u32x2*)(he + (size_t)(ai * 128 + m * 16) * DE) = (u32x2){(unsigned)w0, (unsigned)w1}; }
    }
};
struct EpiDown {
    static constexpr bool PERM = true; static constexpr bool F8 = true; static constexpr bool I8 = false;
    unsigned char* ws; LAS const int* tb;
    __device__ __forceinline__ void operator()(const Acc& acc, const pg8::Unit& u, int wr, int wc, int fr, int fq) const {
        unsigned char* y = ws + WS_X + X_YT + ((size_t)u.pm * 256 + wr * 64 + fr) * DM + u.pn * 256 + wc * 32 + 8 * fq;
#pragma unroll
        for (int ai = 0; ai < 2; ++ai)
#pragma unroll
            for (int m = 0; m < 4; ++m)
#pragma unroll
                for (int bj = 0; bj < 2; ++bj) { const f32x4 v0 = acc[ai][bj][m][0] * (1.0f / F8_WD), v1 = acc[ai][bj][m][1] * (1.0f / F8_WD);
                    int w0 = __builtin_amdgcn_cvt_pk_fp8_f32(v0[0], v0[1], 0, false); w0 = __builtin_amdgcn_cvt_pk_fp8_f32(v0[2], v0[3], w0, true);
                    int w1 = __builtin_amdgcn_cvt_pk_fp8_f32(v1[0], v1[1], 0, false); w1 = __builtin_amdgcn_cvt_pk_fp8_f32(v1[2], v1[3], w1, true);
                    *(u32x2*)(y + (size_t)(ai * 128 + m * 16) * DM + bj * 128) = (u32x2){(unsigned)w0, (unsigned)w1}; }
    }
};
__device__ __forceinline__ void route_tile(LAS unsigned char* lds, unsigned char* ws, const float* H, unsigned* cnt, int layer, int row0, int wave, int lane, bool dry) {
    LAS unsigned* lcnt = (LAS unsigned*)(lds + 65536); LAS unsigned* lbase = lcnt + 32;
    if (wave == 0 && lane < 32) lcnt[lane] = 0u;
    asm volatile("s_waitcnt lgkmcnt(0)" ::: "memory"); __syncthreads();
    int e1 = 0, e2 = 0; unsigned p1 = 0u, p2 = 0u; float g1 = 0.f, g2 = 0.f;
    const int r = lane & 15, g = lane >> 4;
    const u32x2* ap = (const u32x2*)(WSA(bf16_t, WS_HB) + (size_t)(row0 + r) * DM) + g;
    const f32x4* bp = (const f32x4*)(WSA(float, WS_WR) + (size_t)layer * DM * RW) + g * 48 + r;
    f32x4 acc0 = {0.f, 0.f, 0.f, 0.f}, acc1 = acc0, acc2 = acc0; float ss = 0.f;
    constexpr int PD = 4;
    u32x2 A[PD]; f32x4 B0[PD], B1[PD], B2[PD];
#pragma unroll
    for (int sl = 0; sl < PD; ++sl) { A[sl] = ap[4 * sl]; B0[sl] = bp[192 * sl]; B1[sl] = bp[192 * sl + 16]; B2[sl] = bp[192 * sl + 32]; }
#pragma unroll 1
    for (int j0 = 0; j0 < 64; j0 += PD) {
#pragma unroll
        for (int sl = 0; sl < PD; ++sl) {
            const u32x2 ar = A[sl]; const f32x4 b0 = B0[sl], b1 = B1[sl], b2 = B2[sl];
            asm volatile("" :: "v"(ar), "v"(b0), "v"(b1), "v"(b2));
            const f32x4 a = {bf2f(ar.x & 0xffffu), bf2f(ar.x >> 16), bf2f(ar.y & 0xffffu), bf2f(ar.y >> 16)};
            if (j0 + PD < 64) { const int jn = j0 + PD + sl; A[sl] = ap[4 * jn]; B0[sl] = bp[192 * jn]; B1[sl] = bp[192 * jn + 16]; B2[sl] = bp[192 * jn + 32]; }
            ss += (a[0] * a[0] + a[1] * a[1]) + (a[2] * a[2] + a[3] * a[3]);
#pragma unroll
            for (int e = 0; e < 4; ++e) {
                acc0 = __builtin_amdgcn_mfma_f32_16x16x4f32(a[e], b0[e], acc0, 0, 0, 0);
                acc1 = __builtin_amdgcn_mfma_f32_16x16x4f32(a[e], b1[e], acc1, 0, 0, 0);
                acc2 = __builtin_amdgcn_mfma_f32_16x16x4f32(a[e], b2[e], acc2, 0, 0, 0);
            }
        }
    }
    ss = xadd16(ss); ss = xadd32(ss);
    const float rs = 1.0f / sqrtf(ss * (1.0f / DM) + EPS);
    LAS float* L = (LAS float*)(lds + wave * 4096);
#pragma unroll
    for (int q = 0; q < 4; ++q) { L[(4 * g + q) * 48 + r] = acc0[q]; L[(4 * g + q) * 48 + 16 + r] = acc1[q]; L[(4 * g + q) * 48 + 32 + r] = acc2[q]; }
    asm volatile("s_waitcnt lgkmcnt(0)" ::: "memory");
    if (lane < 16) {
        const int row = row0 + lane;
        float lg[40];
#pragma unroll
        for (int q = 0; q < 10; ++q) { const f32x4 v = *(LAS const f32x4*)(L + lane * 48 + 4 * q); lg[4 * q] = v[0] * rs; lg[4 * q + 1] = v[1] * rs; lg[4 * q + 2] = v[2] * rs; lg[4 * q + 3] = v[3] * rs; }
        (dry ? WSA(float, WS_AO + 8 * MiB) : WSA(float, WS_SMALL + SM_RSTD2))[row] = rs;
        int gid = 0; float gm = lg[0];
#pragma unroll
        for (int c = 1; c < 8; ++c) if (lg[c] > gm) { gm = lg[c]; gid = c; }
        float den = 0.f;
#pragma unroll
        for (int c = 0; c < 8; ++c) den += expf(lg[c] - gm);
        const float gw = 1.0f / den;
        float e4[4];
#pragma unroll
        for (int c = 0; c < 4; ++c) { float v = lg[8 + c];
#pragma unroll
            for (int gg = 1; gg < 8; ++gg) v = (gid == gg) ? lg[8 + gg * 4 + c] : v;
            e4[c] = v; }
        int i1 = 0; float v1 = e4[0];
#pragma unroll
        for (int c = 1; c < 4; ++c) if (e4[c] > v1) { v1 = e4[c]; i1 = c; }
        int i2 = -1; float v2 = -INFINITY;
#pragma unroll
        for (int c = 0; c < 4; ++c) if (c != i1 && e4[c] > v2) { v2 = e4[c]; i2 = c; }
        const float ex = expf(v2 - v1); g1 = gw / (1.0f + ex); g2 = gw * ex / (1.0f + ex);
        e1 = gid * 4 + i1; e2 = gid * 4 + i2;
        p1 = __hip_atomic_fetch_add(lcnt + e1, 1u, __ATOMIC_RELAXED, __HIP_MEMORY_SCOPE_WORKGROUP); p2 = __hip_atomic_fetch_add(lcnt + e2, 1u, __ATOMIC_RELAXED, __HIP_MEMORY_SCOPE_WORKGROUP);
    }
    asm volatile("s_waitcnt lgkmcnt(0)" ::: "memory"); __syncthreads();
    if (wave == 0 && lane < 32) lbase[lane] = atomicAdd(cnt + lane * 64, lcnt[lane]);
    asm volatile("s_waitcnt vmcnt(0) lgkmcnt(0)" ::: "memory"); __syncthreads();
    if (lane < 16) {
        const int row = row0 + lane;
        unsigned* list = dry ? WSA(unsigned, WS_AO) : WSA(unsigned, WS_SMALL + SM_LIST);
        const unsigned q1 = lbase[e1] + p1, q2 = lbase[e2] + p2;
        list[(size_t)e1 * T + q1] = (unsigned)row * 2u; list[(size_t)e2 * T + q2] = (unsigned)row * 2u + 1u;
        if (!dry) { unsigned* tsl = WSA(unsigned, WS_SMALL + SM_TSLOT) + (size_t)row * 2; tsl[0] = (q1 << 5) | (unsigned)e1; tsl[1] = (q2 << 5) | (unsigned)e2; }
        float* gt = dry ? WSA(float, WS_AO + 9 * MiB) : WSA(float, WS_SMALL + SM_GATE); gt[row * 2] = g1; gt[row * 2 + 1] = g2;
    }
    asm volatile("s_waitcnt lgkmcnt(0)" ::: "memory");
}
__device__ __forceinline__ void combine_row(unsigned char* ws, float* out, const float* final_norm, int last, int row, int lane, bool dry, LAS const int* tb) {
    const unsigned long long* hb = (const unsigned long long*)(WSA(bf16_t, WS_HB) + (size_t)row * DM) + lane;
    const unsigned t0 = WSA(unsigned, WS_SMALL + SM_TSLOT)[(size_t)row * 2], t1 = WSA(unsigned, WS_SMALL + SM_TSLOT)[(size_t)row * 2 + 1];
    const float g0 = WSA(float, WS_SMALL + SM_GATE)[row * 2], g1 = WSA(float, WS_SMALL + SM_GATE)[row * 2 + 1];
    const size_t a0 = (size_t)tb[t0 & 31u] * 256 + (t0 >> 5), a1 = (size_t)tb[t1 & 31u] * 256 + (t1 >> 5);
    const unsigned* y0 = (const unsigned*)(ws + WS_X + X_YT + a0 * DM) + lane; const unsigned* y1 = (const unsigned*)(ws + WS_X + X_YT + a1 * DM) + lane;
    f32x4 v[4]; float s = 0.f;
#pragma unroll
    for (int j = 0; j < 4; ++j) { const unsigned long long c = hb[64 * j]; const int a = (int)y0[64 * j], b = (int)y1[64 * j];
        v[j].x = bf2f((unsigned)c & 0xffffu) + (g0 * __builtin_amdgcn_cvt_f32_fp8(a, 0) + g1 * __builtin_amdgcn_cvt_f32_fp8(b, 0));
        v[j].y = bf2f(((unsigned)c) >> 16) + (g0 * __builtin_amdgcn_cvt_f32_fp8(a, 1) + g1 * __builtin_amdgcn_cvt_f32_fp8(b, 1));
        v[j].z = bf2f((unsigned)(c >> 32) & 0xffffu) + (g0 * __builtin_amdgcn_cvt_f32_fp8(a, 2) + g1 * __builtin_amdgcn_cvt_f32_fp8(b, 2));
        v[j].w = bf2f((unsigned)(c >> 48)) + (g0 * __builtin_amdgcn_cvt_f32_fp8(a, 3) + g1 * __builtin_amdgcn_cvt_f32_fp8(b, 3));
        s += v[j].x * v[j].x + v[j].y * v[j].y + v[j].z * v[j].z + v[j].w * v[j].w; }
    s = wave_sum(s);
    const float rs = 1.0f / sqrtf(s * (1.0f / DM) + EPS);
    if (last) {
        const f32x4* g = (const f32x4*)final_norm + lane; f32x4* ho = (f32x4*)((dry ? WSA(float, WS_Z + 64 * MiB) : out) + (size_t)row * DM) + lane;
#pragma unroll
        for (int j = 0; j < 4; ++j) { const f32x4 gg = g[64 * j]; ho[64 * j] = (f32x4){v[j].x * rs * gg.x, v[j].y * rs * gg.y, v[j].z * rs * gg.z, v[j].w * rs * gg.w}; }
    } else {
        unsigned long long* o8 = (unsigned long long*)((dry ? WSA(bf16_t, WS_AO) : WSA(bf16_t, WS_HB)) + (size_t)row * DM) + lane;
#pragma unroll
        for (int j = 0; j < 4; ++j) o8[64 * j] = (unsigned long long)pk2(v[j].x, v[j].y) | ((unsigned long long)pk2(v[j].z, v[j].w) << 32);
        float mx = 0.f;
#pragma unroll
        for (int j = 0; j < 4; ++j) mx = fmaxf(fmaxf(mx, fmaxf(fabsf(v[j].x), fabsf(v[j].y))), fmaxf(fabsf(v[j].z), fabsf(v[j].w)));
        mx = wave_max0(mx); const float inv = mx > 0.f ? 127.0f / mx : 0.f;
        if (!dry) { unsigned* a8 = (unsigned*)(ws + WS_Z + Z_A8 + (size_t)row * DM) + lane;
#pragma unroll
            for (int j = 0; j < 4; ++j) a8[64 * j] = q4_i8(v[j].x, v[j].y, v[j].z, v[j].w, inv); }
        if (lane == 0 && !dry) WSA(float, WS_SMALL + SM_RSTD)[row] = rs * (mx * (1.0f / 127.0f));
    }
}

constexpr int AT_NSLOT = 3, AT_KBUF = 0, AT_KSTRIDE = 12288, AT_VBUF = AT_NSLOT * 12288, AT_VSTRIDE = 8192, AT_WSF = AT_VBUF + AT_NSLOT * 8192, AT_OST = AT_WSF + 2048;
static_assert(AT_OST + 65536 <= RING_BYTES, "attention LDS map");
constexpr float AT_THR = 8.0f;
__device__ __forceinline__ int crow(int r, int hi) { return (r & 3) + 8 * (r >> 2) + 4 * hi; }
typedef short s16x4 __attribute__((ext_vector_type(4)));
__device__ __forceinline__ s16x4 vtr(LAS const unsigned char* p) { return __builtin_bit_cast(s16x4, __builtin_amdgcn_ds_read_tr16_b64_v4i16((LAS s16x4*)p)); }
__device__ __forceinline__ unsigned cvtpk(float lo, float hi) { typedef float f2 __attribute__((ext_vector_type(2))); typedef __bf16 b2 __attribute__((ext_vector_type(2))); f2 v = {lo, hi}; b2 b = __builtin_convertvector(v, b2); return __builtin_bit_cast(unsigned, b); }
__device__ __forceinline__ unsigned cvtpk_v(float lo, float hi) { unsigned r; asm volatile("v_cvt_pk_bf16_f32 %0, %1, %2" : "=v"(r) : "v"(lo), "v"(hi)); return r; }
__device__ __forceinline__ float xmax32(float v) { const unsigned a = __builtin_bit_cast(unsigned, v); auto r = __builtin_amdgcn_permlane32_swap(a, a, false, false); const unsigned x = r[0], y = r[1]; return fmaxf(__builtin_bit_cast(float, x), __builtin_bit_cast(float, y)); }

__device__ __forceinline__ void glds16(const void* gsrc, unsigned lds_dst) { unsigned keep;
    asm volatile("s_mov_b32 %0, m0\n\ts_mov_b32 m0, %2\n\ts_nop 0\n\tglobal_load_lds_dwordx4 %1, off\n\ts_mov_b32 m0, %0" : "=&s"(keep) : "v"(gsrc), "s"(lds_dst) : "memory"); }
__device__ __forceinline__ int attn_prefetch(LAS unsigned char* lds, unsigned char* ws, const unsigned un, const int vslot, const int wave, const int lane, bf16x8 (&qn)[6]) {
    const bool nfox = (un & 1u) != 0u; const int qb = 15 - (int)(un >> 7), bh = (int)(un & 127u) >> 1, b = bh >> 3, h = bh & 7;
    const size_t row0 = (size_t)b * SEQ;
    int t0 = 0;
    if (nfox && qb > 0) {
        const float* km2 = WSA(float, WS_SMALL + SM_D + 20480) + (size_t)b * 16 * 8 + h; float kk = 0.f;
        for (int j = 0; j < 16; ++j) kk = fmaxf(kk, km2[j * 8]);
        const float qq = WSA(float, WS_SMALL + SM_D + 16384)[((size_t)b * 16 + qb) * 8 + h];
        const float bound = 2.05f * sqrtf(qq * kk) + 48.0f;
        const float* dt = WSA(float, WS_SMALL + SM_D + 32768) + ((size_t)b * 8 + h) * 64; const float dref = dt[4 * qb - 1];
        const bool far = (lane < 4 * qb) && (dref - dt[lane] <= -bound);
        t0 = __popcll(__ballot(far));
    }
    const bf16_t* Km_ = (nfox ? WSA(bf16_t, WS_X + X_FK) : WSA(bf16_t, WS_Z + Z_KM)) + h * 64;
    const bf16_t* Vm_ = (nfox ? WSA(bf16_t, WS_X + X_FV) : WSA(bf16_t, WS_Z + Z_VM)) + h * 64;
    const int krow = wave * 8 + (lane >> 3), kch = (lane & 7) ^ ((krow >> 1) & 7);
    const bf16_t* ksrc0 = Km_ + (row0 + krow) * 512 + kch * 8 + (size_t)t0 * 64 * 512;
    const int xrow = wave * 16 + (lane >> 2);
    const bf16_t* ksrc1 = nfox ? WSA(bf16_t, WS_X + X_KA) + (((size_t)b * 8 + h) * SEQ + lane) * 8 + (size_t)t0 * 64 * 8
                               : WSA(bf16_t, WS_Z + Z_KR) + (row0 + xrow) * ROPE + ((lane & 3) ^ ((xrow >> 2) & 3)) * 8 + (size_t)t0 * 64 * ROPE;
    const size_t katile = nfox ? (size_t)64 * 8 : (size_t)64 * ROPE;
    const bool k1 = nfox ? (wave == 0) : (wave < 4);
    const bf16_t* vsrc = Vm_ + (row0 + 16 * (wave & 3) + (lane >> 2)) * 512 + (wave >> 2) * 32 + (lane & 3) * 8 + (size_t)t0 * 64 * 512;
    const unsigned lds0 = (unsigned)(unsigned long)lds;
    glds16(ksrc0, (unsigned)__builtin_amdgcn_readfirstlane(lds0 + AT_KBUF + wave * 1024));
    if (k1) glds16(ksrc1, (unsigned)__builtin_amdgcn_readfirstlane(lds0 + AT_KBUF + 8192 + wave * 1024));
    glds16(ksrc0 + (size_t)64 * 512, (unsigned)__builtin_amdgcn_readfirstlane(lds0 + AT_KBUF + AT_KSTRIDE + wave * 1024));
    if (k1) glds16(ksrc1 + katile, (unsigned)__builtin_amdgcn_readfirstlane(lds0 + AT_KBUF + AT_KSTRIDE + 8192 + wave * 1024));
    glds16(vsrc, (unsigned)__builtin_amdgcn_readfirstlane(lds0 + AT_VBUF + vslot * AT_VSTRIDE + wave * 1024));
    { const int r32 = lane & 31, hi = lane >> 5; const size_t qr_ = row0 + (size_t)qb * 256 + wave * 32 + r32;
      const bf16_t* qrow = nfox ? WSA(bf16_t, WS_X + X_FQ) + h * 64 + qr_ * FW + hi * 8 : WSA(bf16_t, WS_Z + Z_QM) + h * MDK + qr_ * (MH * MDK) + hi * 8;
      const bf16_t* q4 = nfox ? WSA(bf16_t, WS_X + X_QA) + h * 8 + qr_ * 64 : qrow + 64;
      const bf16_t* q5 = nfox ? q4 : qrow + 80;
#pragma unroll
      for (int d0 = 0; d0 < 4; ++d0) qn[d0] = *(const bf16x8*)(qrow + d0 * 16);
      qn[4] = *(const bf16x8*)q4; qn[5] = *(const bf16x8*)q5; }
    return t0;
}
template <bool FOX, int ABL>
__device__ __forceinline__ void attn_unit(LAS unsigned char* lds, unsigned char* ws, const int b, const int h, const int qb, const int wave_in, int lane, const bool dry,
                                          const bool pre, const int t0p, const int vs0, const unsigned raw, volatile LAS unsigned* qword, unsigned& unext, int& t0n, int& vsn, bf16x8 (&qx)[6]) {
    asm volatile("" : "+v"(lane));
    int wave = wave_in; asm volatile("" : "+s"(wave));
    constexpr int DKS = FOX ? 5 : 6;
    const int r32 = lane & 31, hi = lane >> 5;
    const size_t row0 = (size_t)b * SEQ; const int q0 = qb * 256;
    const bf16_t* Qm_; const bf16_t* Km_; int qkp; constexpr int kp = 512;
    if (FOX) { Qm_ = WSA(bf16_t, WS_X + X_FQ) + h * 64; Km_ = WSA(bf16_t, WS_X + X_FK) + h * 64; qkp = FW; }
    else { Qm_ = WSA(bf16_t, WS_Z + Z_QM) + h * MDK; Km_ = WSA(bf16_t, WS_Z + Z_KM) + h * 64; qkp = MH * MDK; }
    const bf16_t* Vm_ = FOX ? WSA(bf16_t, WS_X + X_FV) + h * 64 : WSA(bf16_t, WS_Z + Z_VM) + h * 64;
    const bf16_t* QA = WSA(bf16_t, WS_X + X_QA) + h * 8;
    const int krow = wave * 8 + (lane >> 3), kch = (lane & 7) ^ ((krow >> 1) & 7);
    const bf16_t* ksrc0 = Km_ + (row0 + krow) * kp + kch * 8;
    const int xrow = FOX ? lane : (wave * 16 + (lane >> 2));
    const bf16_t* ksrc1 = FOX ? WSA(bf16_t, WS_X + X_KA) + (((size_t)b * 8 + h) * SEQ + lane) * 8 : WSA(bf16_t, WS_Z + Z_KR) + (row0 + xrow) * ROPE + ((lane & 3) ^ ((xrow >> 2) & 3)) * 8;
    const bool k1 = FOX ? (wave == 0) : (wave < 4);
    const bf16_t* vsrc = Vm_ + (row0 + 16 * (wave & 3) + (lane >> 2)) * 512 + (wave >> 2) * 32 + (lane & 3) * 8;
    const size_t ktile = (size_t)64 * kp, katile = FOX ? (size_t)64 * 8 : (size_t)64 * ROPE, vtile = (size_t)64 * 512;
    const unsigned lds0 = (unsigned)(unsigned long)lds;
#define AT_RFL(x) ((unsigned)__builtin_amdgcn_readfirstlane(x))
#define AT_DMAK(t, slot) do { glds16(ksrc0 + (size_t)(t) * ktile, AT_RFL(lds0 + AT_KBUF + (slot) * AT_KSTRIDE + wave * 1024)); \
        if (k1) glds16(ksrc1 + (size_t)(t) * katile, AT_RFL(lds0 + AT_KBUF + (slot) * AT_KSTRIDE + 8192 + wave * 1024)); } while (0)
#define AT_DMAV(t, slot) glds16(vsrc + (size_t)(t) * vtile, AT_RFL(lds0 + AT_VBUF + (slot) * AT_VSTRIDE + wave * 1024))
    int t0 = t0p;
    if (!pre) {
      if (FOX && qb > 0) {
        const float* km2 = WSA(float, WS_SMALL + SM_D + 20480) + (size_t)b * 16 * 8 + h; float kk = 0.f;
        for (int j = 0; j < 16; ++j) kk = fmaxf(kk, km2[j * 8]);
        const float qq = WSA(float, WS_SMALL + SM_D + 16384)[((size_t)b * 16 + qb) * 8 + h];
        const float bound = 2.05f * sqrtf(qq * kk) + 48.0f;
        const float* dt = WSA(float, WS_SMALL + SM_D + 32768) + ((size_t)b * 8 + h) * 64; const float dref = dt[4 * qb - 1];
        const bool far = (lane < 4 * qb) && (dref - dt[lane] <= -bound);
        t0 = __popcll(__ballot(far));
      }
      asm volatile("s_waitcnt lgkmcnt(0)" ::: "memory"); __builtin_amdgcn_s_barrier(); asm volatile("" ::: "memory");
    }
    if (!pre) { AT_DMAK(t0, 0); AT_DMAK(t0 + 1, 1); AT_DMAV(t0, vs0); }
    bf16x8 qr[DKS];
    if (pre) {
#pragma unroll
      for (int d0 = 0; d0 < DKS; ++d0) qr[d0] = qx[d0];
    } else { const bf16_t* qrow = Qm_ + (row0 + q0 + wave * 32 + r32) * qkp + hi * 8;
#pragma unroll
      for (int d0 = 0; d0 < (FOX ? 4 : 6); ++d0) qr[d0] = *(const bf16x8*)(qrow + d0 * 16);
      if (FOX) qr[DKS - 1] = *(const bf16x8*)(QA + (row0 + q0 + wave * 32 + r32) * 64); }
    if (FOX) { if (hi) qr[DKS - 1] = (bf16x8){0, 0, 0, 0, 0, 0, 0, 0}; }
    LAS float* wsf = (LAS float*)(lds + AT_WSF) + wave * 64;
    float mhat = 0.f, l_reg = 0.f; f32x16 o0 = {}, o1 = {}, negm = {};
    const int NT = (q0 + 256) / 64, qrel = wave * 32 + r32;
    const int ksw = (r32 >> 1) & 7, ksx = (r32 >> 2) & 3;
    const int voff = ((lane >> 4) & 1) * 32 + (lane & 3) * 8 + (4 * hi + ((lane & 15) >> 2)) * 64;
#define SBAR() __builtin_amdgcn_sched_barrier(0)
#define AT_KRD(D0, F0, F1) do { \
        if ((D0) < 4) { const int o_ = r32 * 128 + (((2 * (D0) + hi) ^ ksw) << 4); F0 = *(LAS const bf16x8*)(kb + o_); F1 = *(LAS const bf16x8*)(kb + o_ + 4096); } \
        else if (FOX) { const int o_ = 8192 + r32 * 16; F0 = *(LAS const bf16x8*)(kb + o_); F1 = *(LAS const bf16x8*)(kb + o_ + 512); } \
        else { const int o_ = 8192 + r32 * 64 + (((2 * ((D0) - 4) + hi) ^ ksx) << 4); F0 = *(LAS const bf16x8*)(kb + o_); F1 = *(LAS const bf16x8*)(kb + o_ + 2048); } } while (0)
#define AT_VRD(i) do { vlo[i] = vtr(vb + ((i) >> 2) * 4096 + ((i) & 3) * 1024); vhi[i] = vtr(vb + ((i) >> 2) * 4096 + ((i) & 3) * 1024 + 512); } while (0)
#define AT_VFR(i) (bf16x8){vlo[i][0], vlo[i][1], vlo[i][2], vlo[i][3], vhi[i][0], vhi[i][1], vhi[i][2], vhi[i][3]}
#define AT_PIN(x) asm volatile("" : "+v"(x))
#define AT_ROWMAX(C0, C1, RM) do { float a = fmaxf(fmaxf(C0[0], C0[1]), C1[0]), bb = fmaxf(fmaxf(C0[2], C0[3]), C1[1]); a = fmaxf(fmaxf(a, C1[2]), C1[3]); \
        _Pragma("unroll") for (int r = 4; r < 16; r += 4) { a = fmaxf(fmaxf(a, C0[r]), C0[r + 1]); bb = fmaxf(fmaxf(bb, C0[r + 2]), C0[r + 3]); a = fmaxf(fmaxf(a, C1[r]), C1[r + 1]); bb = fmaxf(fmaxf(bb, C1[r + 2]), C1[r + 3]); } \
        RM = xmax32(fmaxf(a, bb)); } while (0)
#define AT_MASK(C0, C1, T) do { const int jb = (T) - (NT - 4); if (jb >= 0) { const int kb0 = 64 * jb + 4 * hi; \
        _Pragma("unroll") for (int r = 0; r < 16; ++r) { const int kv = kb0 + (r & 3) + 8 * (r >> 2); if (kv > qrel) C0[r] = -INFINITY; if (kv + 32 > qrel) C1[r] = -INFINITY; } } } while (0)
#define AT_GAPA(I, P0, P1) do { \
        if ((I) < 4) { sacc += P0[4 * (I)]; sacc += P0[4 * (I) + 1]; sacc += P0[4 * (I) + 2]; sacc += P0[4 * (I) + 3]; } \
        else { sacc += P1[4 * ((I) - 4)]; sacc += P1[4 * ((I) - 4) + 1]; sacc += P1[4 * ((I) - 4) + 2]; sacc += P1[4 * ((I) - 4) + 3]; } \
        AT_PIN(sacc); \
        if ((I) == 0) { pw0[0] = cvtpk_v(P0[0], P0[1]); pw0[1] = cvtpk_v(P0[2], P0[3]); AT_PIN(pw0); } \
        if ((I) == 1) { pw0[2] = cvtpk_v(P0[4], P0[5]); pw0[3] = cvtpk_v(P0[6], P0[7]); AT_PIN(pw0); } \
        if ((I) == 2) { pw1[0] = cvtpk_v(P0[8], P0[9]); pw1[1] = cvtpk_v(P0[10], P0[11]); AT_PIN(pw1); } \
        if ((I) == 3) { pw1[2] = cvtpk_v(P0[12], P0[13]); pw1[3] = cvtpk_v(P0[14], P0[15]); AT_PIN(pw1); } \
        if ((I) == 4) { pw2[0] = cvtpk_v(P1[0], P1[1]); pw2[1] = cvtpk_v(P1[2], P1[3]); AT_PIN(pw2); } \
        if ((I) == 5) { pw2[2] = cvtpk_v(P1[4], P1[5]); pw2[3] = cvtpk_v(P1[6], P1[7]); AT_PIN(pw2); } \
        if ((I) == 6) { pw3[0] = cvtpk_v(P1[8], P1[9]); pw3[1] = cvtpk_v(P1[10], P1[11]); AT_PIN(pw3); } \
        if ((I) == 7) { pw3[2] = cvtpk_v(P1[12], P1[13]); pw3[3] = cvtpk_v(P1[14], P1[15]); AT_PIN(pw3); } } while (0)
#define AT_STEP(C0, C1, P0, P1, T, KS, VS, KS2, VS2) do { \
        LAS const unsigned char* kb = lds + AT_KBUF + (KS) * AT_KSTRIDE; LAS const unsigned char* vb = lds + AT_VBUF + (VS) * AT_VSTRIDE + voff; \
        bf16x8 kfa0, kfa1, kfb0, kfb1; s16x4 vlo[8], vhi[8]; u32x4 pw0, pw1, pw2, pw3; float sacc = 0.f; \
        SBAR(); AT_KRD(0, kfa0, kfa1); SBAR(); \
          \
        _Pragma("unroll") for (int d0 = 0; d0 < DKS; ++d0) { \
            if (d0 + 1 < DKS) { if (d0 & 1) AT_KRD(d0 + 1, kfa0, kfa1); else AT_KRD(d0 + 1, kfb0, kfb1); } \
            if (2 * d0 < 8) AT_VRD(2 * d0 < 8 ? (((2 * d0) & 1) * 4 + ((2 * d0) >> 1)) : 0); \
            SBAR(); \
            C0 = __builtin_amdgcn_mfma_f32_32x32x16_bf16((d0 & 1) ? kfb0 : kfa0, qr[d0], d0 == 0 ? negm : C0, 0, 0, 0); \
            if (2 * d0 < 8) AT_GAPA(2 * d0 < 8 ? 2 * d0 : 0, P0, P1); \
            SBAR(); \
            if (2 * d0 + 1 < 8) AT_VRD(2 * d0 + 1 < 8 ? (((2 * d0 + 1) & 1) * 4 + ((2 * d0 + 1) >> 1)) : 0); \
            SBAR(); \
            C1 = __builtin_amdgcn_mfma_f32_32x32x16_bf16((d0 & 1) ? kfb1 : kfa1, qr[d0], d0 == 0 ? negm : C1, 0, 0, 0); \
            if (2 * d0 + 1 < 8) AT_GAPA(2 * d0 + 1 < 8 ? 2 * d0 + 1 : 0, P0, P1); \
            SBAR(); } \
        l_reg += sacc; \
        if ((T) + 2 < NT) AT_DMAK((T) + 2, KS2); \
        if ((T) + 1 < NT) AT_DMAV((T) + 1, VS2); \
        AT_MASK(C0, C1, T); \
        float rm; AT_ROWMAX(C0, C1, rm); \
        bool resc = false; \
        if (__builtin_expect(__any(rm > AT_THR), 0)) { const float dl = fmaxf(rm, 0.f); mhat += dl; \
            _Pragma("unroll") for (int r = 0; r < 16; ++r) { C0[r] -= dl; C1[r] -= dl; negm[r] = -mhat; } \
            const float f = __builtin_amdgcn_exp2f(-dl); l_reg *= f; { int ro_ = r32; asm volatile("" : "+v"(ro_)); if (hi == 0) wsf[ro_] = f; } resc = true; } \
        SBAR(); \
          \
        AT_GAPB(o0, pw0, 0, C0, 0); AT_GAPB(o1, pw0, 4, C0, 4); AT_GAPB(o0, pw1, 1, C0, 8); AT_GAPB(o1, pw1, 5, C0, 12); \
        AT_GAPB(o0, pw2, 2, C1, 0); AT_GAPB(o1, pw2, 6, C1, 4); AT_GAPB(o0, pw3, 3, C1, 8); AT_GAPB(o1, pw3, 7, C1, 12); \
        if (resc) { asm volatile("s_waitcnt lgkmcnt(0)" ::: "memory"); \
            _Pragma("unroll") for (int r = 0; r < 16; ++r) { const float fr_ = wsf[crow(r, hi)]; o0[r] *= fr_; o1[r] *= fr_; } } \
    } while (0)
#define AT_GAPB(ODST, PW, VI, X, B) do { ODST = __builtin_amdgcn_mfma_f32_32x32x16_bf16(__builtin_bit_cast(bf16x8, PW), AT_VFR(VI), ODST, 0, 0, 0); \
        X[B] = __builtin_amdgcn_exp2f(X[B]); X[(B) + 1] = __builtin_amdgcn_exp2f(X[(B) + 1]); X[(B) + 2] = __builtin_amdgcn_exp2f(X[(B) + 2]); X[(B) + 3] = __builtin_amdgcn_exp2f(X[(B) + 3]); AT_PIN(X); SBAR(); } while (0)
#define AT_ENDSTEP(T) do { if ((T) + 2 < NT) { if (k1) asm volatile("s_waitcnt vmcnt(3) lgkmcnt(0)" ::: "memory"); else asm volatile("s_waitcnt vmcnt(2) lgkmcnt(0)" ::: "memory"); } \
        else asm volatile("s_waitcnt vmcnt(0) lgkmcnt(0)" ::: "memory"); \
        __builtin_amdgcn_s_barrier(); asm volatile("" ::: "memory"); } while (0)
    f32x16 pa0, pa1, pb0, pb1;
    if (pre) asm volatile("s_waitcnt vmcnt(4)" ::: "memory");
    else if (k1) asm volatile("s_waitcnt vmcnt(3)" ::: "memory"); else asm volatile("s_waitcnt vmcnt(2)" ::: "memory");
    __builtin_amdgcn_s_barrier(); asm volatile("" ::: "memory");
    AT_DMAK(t0 + 2, 2); AT_DMAV(t0 + 1, (vs0 == 2 ? 0 : vs0 + 1));
    { LAS const unsigned char* kb = lds + AT_KBUF;
#pragma unroll
      for (int d0 = 0; d0 < DKS; ++d0) { bf16x8 f0, f1; AT_KRD(d0, f0, f1);
          pa0 = __builtin_amdgcn_mfma_f32_32x32x16_bf16(f0, qr[d0], d0 == 0 ? negm : pa0, 0, 0, 0); pa1 = __builtin_amdgcn_mfma_f32_32x32x16_bf16(f1, qr[d0], d0 == 0 ? negm : pa1, 0, 0, 0); }
      AT_MASK(pa0, pa1, t0);
      float rm; AT_ROWMAX(pa0, pa1, rm); mhat = rm;
#pragma unroll
      for (int r = 0; r < 16; ++r) { pa0[r] = __builtin_amdgcn_exp2f(pa0[r] - rm); pa1[r] = __builtin_amdgcn_exp2f(pa1[r] - rm); negm[r] = -mhat; } }
    if (t0 + 2 < NT) { if (k1) asm volatile("s_waitcnt vmcnt(3) lgkmcnt(0)" ::: "memory"); else asm volatile("s_waitcnt vmcnt(2) lgkmcnt(0)" ::: "memory"); }
    else asm volatile("s_waitcnt vmcnt(0) lgkmcnt(0)" ::: "memory");
    if (wave == 0 && lane == 0) { unsigned rw = raw; asm volatile("" : "+v"(rw)); qword[0] = rw; }
    __builtin_amdgcn_s_barrier(); asm volatile("" ::: "memory");
    int t = t0 + 1;
    int ks = 1, vs = vs0;
#define AT_NEXT3(x) ((x) == 2 ? 0 : (x) + 1)
#define AT_PREV3(x) ((x) == 0 ? 2 : (x) - 1)
    if ((NT - t) & 1) {
        AT_STEP(pb0, pb1, pa0, pa1, t, ks, vs, AT_PREV3(ks), AT_NEXT3(AT_NEXT3(vs))); AT_ENDSTEP(t);
        pa0 = pb0; pa1 = pb1; ++t; ks = AT_NEXT3(ks); vs = AT_NEXT3(vs);
    }
#pragma unroll 1
    for (; t < NT; t += 2) {
        AT_STEP(pb0, pb1, pa0, pa1, t, ks, vs, AT_PREV3(ks), AT_NEXT3(AT_NEXT3(vs))); AT_ENDSTEP(t);
        ks = AT_NEXT3(ks); vs = AT_NEXT3(vs);
        AT_STEP(pa0, pa1, pb0, pb1, t + 1, ks, vs, AT_PREV3(ks), AT_NEXT3(AT_NEXT3(vs))); AT_ENDSTEP(t + 1);
        ks = AT_NEXT3(ks); vs = AT_NEXT3(vs);
    }
    unext = qword[0]; vsn = (vs == 2 ? 0 : vs + 1); t0n = 0;
    if (unext < 2048u) t0n = attn_prefetch(lds, ws, unext, vsn, wave, lane, qx);
    else {
#pragma unroll
        for (int d0 = 0; d0 < 6; ++d0) qx[d0] = qr[d0 < DKS ? d0 : 0]; }
    { float sacc = 0.f;
#pragma unroll
      for (int r = 0; r < 16; ++r) sacc += pa0[r] + pa1[r];
      l_reg += sacc;
      const u32x4 pw0 = {cvtpk(pa0[0], pa0[1]), cvtpk(pa0[2], pa0[3]), cvtpk(pa0[4], pa0[5]), cvtpk(pa0[6], pa0[7])}, pw1 = {cvtpk(pa0[8], pa0[9]), cvtpk(pa0[10], pa0[11]), cvtpk(pa0[12], pa0[13]), cvtpk(pa0[14], pa0[15])};
      const u32x4 pw2 = {cvtpk(pa1[0], pa1[1]), cvtpk(pa1[2], pa1[3]), cvtpk(pa1[4], pa1[5]), cvtpk(pa1[6], pa1[7])}, pw3 = {cvtpk(pa1[8], pa1[9]), cvtpk(pa1[10], pa1[11]), cvtpk(pa1[12], pa1[13]), cvtpk(pa1[14], pa1[15])};
      LAS const unsigned char* vb = lds + AT_VBUF + vs * AT_VSTRIDE + voff; s16x4 vlo[8], vhi[8];
#pragma unroll
      for (int i = 0; i < 8; ++i) AT_VRD(i);
      o0 = __builtin_amdgcn_mfma_f32_32x32x16_bf16(__builtin_bit_cast(bf16x8, pw0), AT_VFR(0), o0, 0, 0, 0); o1 = __builtin_amdgcn_mfma_f32_32x32x16_bf16(__builtin_bit_cast(bf16x8, pw0), AT_VFR(4), o1, 0, 0, 0);
      o0 = __builtin_amdgcn_mfma_f32_32x32x16_bf16(__builtin_bit_cast(bf16x8, pw1), AT_VFR(1), o0, 0, 0, 0); o1 = __builtin_amdgcn_mfma_f32_32x32x16_bf16(__builtin_bit_cast(bf16x8, pw1), AT_VFR(5), o1, 0, 0, 0);
      o0 = __builtin_amdgcn_mfma_f32_32x32x16_bf16(__builtin_bit_cast(bf16x8, pw2), AT_VFR(2), o0, 0, 0, 0); o1 = __builtin_amdgcn_mfma_f32_32x32x16_bf16(__builtin_bit_cast(bf16x8, pw2), AT_VFR(6), o1, 0, 0, 0);
      o0 = __builtin_amdgcn_mfma_f32_32x32x16_bf16(__builtin_bit_cast(bf16x8, pw3), AT_VFR(3), o0, 0, 0, 0); o1 = __builtin_amdgcn_mfma_f32_32x32x16_bf16(__builtin_bit_cast(bf16x8, pw3), AT_VFR(7), o1, 0, 0, 0); }
#undef AT_STEP
#undef AT_GAPA
#undef AT_GAPB
#undef AT_ENDSTEP
#undef AT_KRD
#undef AT_VRD
#undef AT_VFR
#undef AT_PIN
#undef AT_ROWMAX
#undef AT_MASK
#undef AT_NEXT3
#undef AT_PREV3
#undef SBAR
#undef AT_DMAK
#undef AT_DMAV
#undef AT_RFL
    l_reg = xadd32(l_reg);
    if (hi == 0) wsf[32 + r32] = l_reg;
    asm volatile("s_waitcnt lgkmcnt(0)" ::: "memory");
    LAS float* stg = (LAS float*)(lds + AT_OST) + wave * 2048;
#pragma unroll
    for (int r = 0; r < 16; ++r) { const int orow = crow(r, hi); const float il = __builtin_amdgcn_rcpf(wsf[32 + orow]);
        stg[orow * 64 + r32] = o0[r] * il; stg[orow * 64 + 32 + r32] = o1[r] * il; }
    asm volatile("s_waitcnt lgkmcnt(0)" ::: "memory");
    unsigned char* ao = ws + (dry ? WS_HB : WS_AO) + (row0 + q0 + wave * 32) * DM + (FOX ? 0 : FW) + h * 64;
#pragma unroll
    for (int i = 0; i < 4; ++i) { const int row = i * 8 + (lane >> 3), ch = lane & 7;
        const f32x4 a = *(LAS const f32x4*)(stg + row * 64 + ch * 8), bq = *(LAS const f32x4*)(stg + row * 64 + ch * 8 + 4);
        float ss = sq8(a, bq); ss += dppf<0xB1>(ss); ss += dppf<0x4E>(ss); ss += dppf<0x141>(ss);
        const float rs = 1.0f / sqrtf(ss * (1.0f / 64.0f) + EPS);
        const float qs = rs * (127.0f / AO_C);
        *(u32x2*)(ao + (size_t)row * DM + ch * 8) = (u32x2){q4_i8c(a[0], a[1], a[2], a[3], qs), q4_i8c(bq[0], bq[1], bq[2], bq[3], qs)}; }
    asm volatile("" : "+v"(qx[0]), "+v"(qx[1]), "+v"(qx[2]), "+v"(qx[3]), "+v"(qx[4]), "+v"(qx[5]));
}
constexpr int CW_ATTQ = 15360;
template <int ABL>
__device__ __forceinline__ void attn_phase(LAS unsigned char* lds, unsigned char* ws, unsigned* qhead, int wave, int lane, bool dry) {
    volatile LAS unsigned* qw = (volatile LAS unsigned*)(lds + MISC_OFF + 64);
    const bool leader = (wave == 0 && lane == 0);
    if (leader) qw[0] = atomicAdd(qhead, 1u);
    asm volatile("s_waitcnt vmcnt(0) lgkmcnt(0)" ::: "memory"); __syncthreads();
    unsigned u = qw[0];
    bool pre = false; int t0p = 0, vs0 = 0, par = 0; bf16x8 qx[6];
#pragma unroll 1
    while (u < 2048u) {
        unsigned raw;
        if (leader) { const unsigned one = 1u; asm volatile("global_atomic_add %0, %1, %2, off sc0" : "=v"(raw) : "v"(qhead), "v"(one) : "memory"); }
        const int qb = 15 - (int)(u >> 7), bh = (int)(u & 127u) >> 1, b = bh >> 3, h = bh & 7;
        unsigned un = 2048u; int t0n = 0, vsn = 0;
        if (u & 1u) attn_unit<true, ABL>(lds, ws, b, h, qb, wave, lane, dry, pre, t0p, vs0, raw, qw + 1 + par, un, t0n, vsn, qx);
        else attn_unit<false, ABL>(lds, ws, b, h, qb, wave, lane, dry, pre, t0p, vs0, raw, qw + 1 + par, un, t0n, vsn, qx);
        u = un; pre = true; t0p = t0n; vs0 = vsn; par ^= 1;
    }
    asm volatile("s_waitcnt vmcnt(0) lgkmcnt(0)" ::: "memory"); __syncthreads();
}

#define XB_TMO      128
#define XB_XCNT(j)  (256  + 64 * (j))
#define XB_XSUB(j)  (1280 + 64 * (j))
#define XB_XGEN(j)  (2304 + 64 * (j))
#define XB_TOP      3328
#define XB_TOPGEN   3392
#define XCD_BAR_WORDS 3456
#define XB_SPIN_CAP (1u << 18)
constexpr int CW_BAR = 4096;
__device__ __forceinline__ unsigned xb_ld(unsigned* p)              { return __hip_atomic_load(p, __ATOMIC_RELAXED, __HIP_MEMORY_SCOPE_AGENT); }
__device__ __forceinline__ unsigned xb_add(unsigned* p, unsigned v) { return __hip_atomic_fetch_add(p, v, __ATOMIC_RELAXED, __HIP_MEMORY_SCOPE_AGENT); }
__device__ __forceinline__ unsigned xb_xcc_id() { return (unsigned)__builtin_amdgcn_s_getreg((3 << 11) | 20) & 0xFu; }
#define XB_SPIN(cond, bar) do { unsigned _sp = 0; while (cond) { __builtin_amdgcn_s_sleep(1); \
    if ((++_sp & 255u) == 0u) { if (xb_ld(&(bar)[XB_TMO])) break; if (_sp > XB_SPIN_CAP) { atomicAdd(&(bar)[XB_TMO], 1u); break; } } } } while (0)
struct XcdBarrier { unsigned* bar; unsigned x; volatile LAS unsigned* st; };
__device__ __forceinline__ XcdBarrier xcd_barrier_post(unsigned* bar, volatile LAS unsigned* st) {
    XcdBarrier b; b.bar = bar; b.x = xb_xcc_id(); b.st = st;
    if (threadIdx.x == 0) (void)xb_add(&bar[XB_XCNT(b.x)], 1u);
    return b;
}
__device__ __forceinline__ void xcd_barrier_complete(unsigned* bar, unsigned x, unsigned& nloc, unsigned& nx) {
    const unsigned G = gridDim.x * gridDim.y * gridDim.z;
    unsigned sum, cnt, mine, sp = 0u;
    for (;;) {
        sum = 0u; cnt = 0u; mine = 0u;
#pragma unroll
        for (unsigned j = 0; j < 16; ++j) { const unsigned c = xb_ld(&bar[XB_XCNT(j)]); sum += c; cnt += (c > 0u) ? 1u : 0u; mine = (j == x) ? c : mine; }
        if (sum == G) break;
        __builtin_amdgcn_s_sleep(1);
        if ((++sp & 255u) == 0u) { if (xb_ld(&bar[XB_TMO])) break; if (sp > XB_SPIN_CAP) { atomicAdd(&bar[XB_TMO], 1u); break; } }
    }
    nloc = mine > 0u ? mine : 1u; nx = cnt > 0u ? cnt : 1u;
}
__device__ __forceinline__ void xcd_barrier(const XcdBarrier& b) {
    asm volatile("s_waitcnt vmcnt(0)" ::: "memory");
    __syncthreads();
    if (threadIdx.x == 0) {
        unsigned* bar = b.bar;
        __builtin_amdgcn_s_waitcnt(0);
        unsigned nloc = b.st[0], nx = b.st[1];
        if (nloc == 0u) { xcd_barrier_complete(bar, b.x, nloc, nx); b.st[0] = nloc; b.st[1] = nx; }
        const unsigned old = xb_add(&bar[XB_XSUB(b.x)], 1u);
        const unsigned gen = old / nloc;
        if (old + 1u == (gen + 1u) * nloc) {
            __builtin_amdgcn_fence(__ATOMIC_RELEASE, "agent");
            asm volatile("s_waitcnt vmcnt(0)" ::: "memory");
            const unsigned og = xb_add(&bar[XB_TOP], 1u);
            const unsigned tg = og / nx;
            if (og + 1u == (tg + 1u) * nx) xb_add(&bar[XB_TOPGEN], 1u);
            else XB_SPIN(xb_ld(&bar[XB_TOPGEN]) == tg, bar);
            __builtin_amdgcn_fence(__ATOMIC_ACQUIRE, "agent");
            xb_add(&bar[XB_XGEN(b.x)], 1u);
            asm volatile("s_waitcnt vmcnt(0)" ::: "memory");
        } else {
            XB_SPIN(xb_ld(&bar[XB_XGEN(b.x)]) == gen, bar);
            __builtin_amdgcn_fence(__ATOMIC_ACQUIRE, "agent");
            asm volatile("s_waitcnt vmcnt(0)" ::: "memory");
        }
    }
    __syncthreads();
}

__device__ __forceinline__ void scan_tile(unsigned char* ws, int bt, int lane) {
    asm volatile("" : "+v"(lane));
    const int tile = bt & 15; const size_t r0 = (size_t)bt * 256 + (size_t)lane * 4;
    const float* ts = WSA(float, WS_SMALL + SM_D) + (size_t)(bt - tile) * 16;
    f32x4 base0 = {0.f, 0.f, 0.f, 0.f}, base1 = base0;
    for (int j = 0; j < tile; ++j) { const f32x4* p = (const f32x4*)(ts + j * 16); base0 += p[0] + p[2]; base1 += p[1] + p[3]; }
    const f32x4* lf = (const f32x4*)(WSA(float, WS_SMALL + SM_LF) + r0 * 8);
    f32x4 v[4][2];
#pragma unroll
    for (int i = 0; i < 4; ++i) { v[i][0] = lf[2 * i]; v[i][1] = lf[2 * i + 1]; }
#pragma unroll
    for (int i = 1; i < 4; ++i) { v[i][0] += v[i - 1][0]; v[i][1] += v[i - 1][1]; }
    f32x4 p0 = v[3][0], p1 = v[3][1];
#pragma unroll
    for (int o = 1; o < 64; o <<= 1) {
#pragma unroll
        for (int j = 0; j < 4; ++j) { const float x0 = p0[j], x1 = p1[j];
            const int y0 = __builtin_amdgcn_ds_bpermute((lane - o) << 2, __builtin_bit_cast(int, x0)), y1 = __builtin_amdgcn_ds_bpermute((lane - o) << 2, __builtin_bit_cast(int, x1));
            if (lane >= o) { p0[j] = x0 + __builtin_bit_cast(float, y0); p1[j] = x1 + __builtin_bit_cast(float, y1); } } }
    const f32x4 e0 = base0 + (p0 - v[3][0]), e1 = base1 + (p1 - v[3][1]);
    if (lane < 16) { const int h = lane & 7, which = lane >> 3;
        const f32x4 t4 = *(const f32x4*)(WSA(float, WS_SMALL + SM_D + 65536) + (((size_t)which * 128 + bt) * 8 + h) * 4);
        WSA(float, WS_SMALL + SM_D + (which ? 20480 : 16384))[bt * 8 + h] = fmaxf(t4[0], t4[1]) + fmaxf(t4[2], t4[3]); }
    bf16_t* qa = WSA(bf16_t, WS_X + X_QA) + r0 * 64; bf16_t* ka = WSA(bf16_t, WS_X + X_KA) + ((size_t)(bt >> 4) * 8 * SEQ + (size_t)(bt & 15) * 256 + (size_t)lane * 4) * 8;
    unsigned one = 0x3f80u; asm volatile("" : "+v"(one));
#pragma unroll
    for (int i = 0; i < 4; ++i)
#pragma unroll
        for (int h = 0; h < 8; ++h) { const float D = ((h < 4) ? (e0[h & 3] + v[i][0][h & 3]) : (e1[h & 3] + v[i][1][h & 3])) * LOG2E;
            const unsigned d1 = f2bf(D); const float r1 = D - bf2f(d1); const unsigned d2 = f2bf(r1); const float r2 = r1 - bf2f(d2); const unsigned d3 = f2bf(r2);
            *(u32x4*)(qa + i * 64 + h * 8) = (u32x4){one | (one << 16), one | (d1 << 16), d2 | (d3 << 16), 0u};
            *(u32x4*)(ka + ((size_t)h * SEQ + i) * 8) = (u32x4){(d1 ^ 0x8000u) | ((d2 ^ 0x8000u) << 16), (d3 ^ 0x8000u) | (one << 16), one | (one << 16), 0u};
            if (i == 3 && (lane & 15) == 15) WSA(float, WS_SMALL + SM_D + 32768)[((size_t)(bt >> 4) * 8 + h) * 64 + (bt & 15) * 4 + (lane >> 4)] = D; }
}

__device__ __forceinline__ void pro_item(const float* __restrict__ src, const float* __restrict__ src2, const float* __restrict__ gain, const float* __restrict__ gain2, bf16_t* __restrict__ dst,
                                         const int K, const int Nsrc, const int Ndst, const int mode, LAS float* scr, const int item, const int lane, const float f8s = 0.f) {
    const int nblk = Ndst / 32, kb = item / nblk, nb = item % nblk, k0 = 64 * kb, n0 = 32 * nb;
    const int n = n0 + (lane & 31); int col; const float* sp = src;
    if (mode == 0) col = map_in(n); else if (mode == 1) col = map_uq(n); else if (mode == 2) col = map_ukv(n); else if (mode == 3) col = n;
    else { const int pn = n >> 8, w = n & 255; if (w < 128) col = pn * 128 + w; else { col = pn * 128 + (w - 128); sp = src2; } }
    float vals[32];
#pragma unroll
    for (int i = 0; i < 32; ++i) { const int k = k0 + 2 * i + (lane >> 5); vals[i] = col >= 0 ? sp[(size_t)k * Nsrc + col] : 0.f; }
#pragma unroll
    for (int i = 0; i < 32; ++i) { const int kk = 2 * i + (lane >> 5), k = k0 + kk;
        float g = 1.f; if (gain) g = (gain2 && k >= 512) ? gain2[k - 512] : gain[k];
        scr[kk * 33 + (lane & 31)] = vals[i] * g; }
    asm volatile("s_waitcnt lgkmcnt(0)" ::: "memory");
    const int c = lane & 7;
#pragma unroll
    for (int j = 0; j < 4; ++j) { const int nn = (lane >> 3) + 8 * j; const LAS float* sq = scr + (8 * c) * 33 + nn;
        if (f8s != 0.f) {
            int w0 = __builtin_amdgcn_cvt_pk_fp8_f32(sq[0 * 33] * f8s, sq[1 * 33] * f8s, 0, false); w0 = __builtin_amdgcn_cvt_pk_fp8_f32(sq[2 * 33] * f8s, sq[3 * 33] * f8s, w0, true);
            int w1 = __builtin_amdgcn_cvt_pk_fp8_f32(sq[4 * 33] * f8s, sq[5 * 33] * f8s, 0, false); w1 = __builtin_amdgcn_cvt_pk_fp8_f32(sq[6 * 33] * f8s, sq[7 * 33] * f8s, w1, true);
            *(u32x2*)((unsigned char*)dst + (size_t)(n0 + nn) * K + k0 + 8 * c) = (u32x2){(unsigned)w0, (unsigned)w1};
        } else {
        u32x4 o; o.x = pk2(sq[0 * 33], sq[1 * 33]); o.y = pk2(sq[2 * 33], sq[3 * 33]); o.z = pk2(sq[4 * 33], sq[5 * 33]); o.w = pk2(sq[6 * 33], sq[7 * 33]);
        *(u32x4*)(dst + (size_t)(n0 + nn) * K + k0 + 8 * c) = o; } }
    asm volatile("s_waitcnt lgkmcnt(0)" ::: "memory");
}
template <bool WO>
__device__ __forceinline__ void pro_win_i8(LAS unsigned char* lds, const float* __restrict__ src, const float* __restrict__ gain, const float* __restrict__ gain2, unsigned char* __restrict__ dst8, float* __restrict__ wcs, const int nb, const int wave, const int lane) {
    LAS float* scr = (LAS float*)(lds + wave * 16384); LAS float* red = (LAS float*)(lds + 8448);
    const int n0 = 32 * nb, n = n0 + (lane & 31), col = WO ? n : map_in(n), kh = lane >> 5; constexpr int NS = WO ? DM : IN_W;
    const float* gv = (WO && wave >= 4) ? gain2 - 512 : gain;
    float va[32], vb[32]; float mx = 0.f;
#pragma unroll
    for (int i = 0; i < 32; ++i) { const int k = 128 * wave + 2 * i + kh; va[i] = col >= 0 ? src[(size_t)k * NS + col] * gv[k] : 0.f; vb[i] = col >= 0 ? src[(size_t)(k + 64) * NS + col] * gv[k + 64] : 0.f; }
#pragma unroll
    for (int i = 0; i < 32; ++i) mx = fmaxf(mx, fmaxf(fabsf(va[i]), fabsf(vb[i])));
    mx = xmx32(mx);
    if (lane < 32) red[wave * 32 + lane] = mx;
    asm volatile("s_waitcnt lgkmcnt(0)" ::: "memory"); __syncthreads();
#pragma unroll
    for (int w = 0; w < 8; ++w) mx = fmaxf(mx, red[w * 32 + (lane & 31)]);
    const float inv = mx > 0.f ? 127.0f / mx : 0.f;
    if (wave == 0 && lane < 32) wcs[n] = mx * (1.0f / 127.0f);
#pragma unroll
    for (int h = 0; h < 2; ++h) {
#pragma unroll
        for (int i = 0; i < 32; ++i) scr[(2 * i + kh) * 33 + (lane & 31)] = __builtin_rintf((h ? vb[i] : va[i]) * inv);
        asm volatile("s_waitcnt lgkmcnt(0)" ::: "memory");
        const int c = lane & 7;
#pragma unroll
        for (int j = 0; j < 4; ++j) { const int nn = (lane >> 3) + 8 * j; const LAS float* sq = scr + (8 * c) * 33 + nn;
            const unsigned w0 = q4_i8(sq[0 * 33], sq[1 * 33], sq[2 * 33], sq[3 * 33], 1.0f), w1 = q4_i8(sq[4 * 33], sq[5 * 33], sq[6 * 33], sq[7 * 33], 1.0f);
            *(u32x2*)(dst8 + (size_t)(n0 + nn) * DM + 128 * wave + 64 * h + 8 * c) = (u32x2){w0, w1}; }
        asm volatile("s_waitcnt lgkmcnt(0)" ::: "memory");
    }
    __syncthreads();
}
__device__ __forceinline__ void prologue_phase(LAS unsigned char* lds, unsigned char* ws, const MkArgs& args, int vcu, int G, int wave, int lane) {
    LAS float* scr = (LAS float*)(lds + wave * 16384);
    const int gw = vcu * NWAVES + wave, NGW = G * NWAVES;
    constexpr int I_IN = 16 * 64, I_UQ = 4 * 24, I_UKV = 2 * 32, I_WO = 16 * 32, I_GU = 16 * 16, I_D = 4 * 32, I_L = I_IN + I_UQ + I_UKV + I_WO + NE * (I_GU + I_D);
    const float* attn_norm = args.in[2]; const float* w_in = args.in[3]; const float* q_norm = args.in[5]; const float* w_uq = args.in[6]; const float* kv_norm = args.in[7]; const float* w_ukv = args.in[8];
    const float* fox_on = args.in[9]; const float* mla_on = args.in[10]; const float* w_o = args.in[11]; const float* ffn_norm = args.in[12]; const float* w_group = args.in[13]; const float* w_router = args.in[14];
    const float* w_gate = args.in[15]; const float* w_up = args.in[16]; const float* w_down = args.in[17];
    if (vcu < DEPTH * (IN_WP / 32)) { const int l = vcu / (IN_WP / 32), nb = vcu % (IN_WP / 32);
        pro_win_i8<false>(lds, w_in + (size_t)l * DM * IN_W, attn_norm + l * DM, nullptr, ws + WS_WIN + (size_t)l * IN_WP * DM, WSA(float, WS_SMALL + SM_WCS) + l * IN_WP, nb, wave, lane); }
    else if (vcu < DEPTH * (IN_WP / 32) + DEPTH * (DM / 32)) { const int j = vcu - DEPTH * (IN_WP / 32), l = j / (DM / 32), nb = j % (DM / 32);
        pro_win_i8<true>(lds, w_o + (size_t)l * DM * DM, fox_on + l * FW, mla_on + l * MW, ws + WS_WO + (size_t)l * DM * DM, WSA(float, WS_SMALL + SM_WCS2) + l * DM, nb, wave, lane); }
#pragma unroll 1
    for (int it = gw; it < DEPTH * I_L; it += NGW) {
        const int l = it / I_L; int r = it % I_L;
        if (r < I_IN) continue; r -= I_IN;
        if (r < I_UQ) { pro_item(w_uq + (size_t)l * QL * 768, nullptr, q_norm + l * QL, nullptr, WSA(bf16_t, WS_WUQ) + (size_t)l * 768 * QL, QL, 768, 768, 1, scr, r, lane); continue; } r -= I_UQ;
        if (r < I_UKV) { pro_item(w_ukv + (size_t)l * KVL * 1024, nullptr, kv_norm + l * KVL, nullptr, WSA(bf16_t, WS_WUKV) + (size_t)l * 1024 * KVL, KVL, 1024, 1024, 2, scr, r, lane); continue; } r -= I_UKV;
        if (r < I_WO) continue; r -= I_WO;
        if (r < NE * I_GU) { const size_t le = (size_t)l * NE + r / I_GU;
            pro_item(w_gate + le * DM * DE, w_up + le * DM * DE, ffn_norm + l * DM, nullptr, (bf16_t*)(ws + WS_WGU + le * 512 * DM), DM, DE, 512, 4, scr, r % I_GU, lane, F8_WGU); continue; } r -= NE * I_GU;
        { const size_t le = (size_t)l * NE + r / I_D;
          pro_item(w_down + le * DE * DM, nullptr, nullptr, nullptr, (bf16_t*)(ws + WS_WD + le * DM * DE), DE, DM, DM, 3, scr, r % I_D, lane, F8_WD); }
    }
    const int gt = gw * 64 + lane, NGT = NGW * 64;
    for (int i = gt; i < DEPTH * DM * RW; i += NGT) { const int l = i / (DM * RW), k = (i / RW) % DM, c = i % RW;
        float v = 0.f; if (c < 8) v = w_group[((size_t)l * DM + k) * NG + c]; else if (c < 40) v = w_router[((size_t)l * DM + k) * NE + (c - 8)];
        WSA(float, WS_WR)[(size_t)l * DM * RW + ((size_t)(k >> 2) * RW + c) * 4 + (k & 3)] = v * ffn_norm[l * DM + k]; }
    for (int i = gt; i < T * 16; i += NGT) { const int t = i >> 4, j = i & 15;
        const float inv = powf(10000.0f, -(float)j / 16.0f); const float ang = (float)args.pos[t] * inv;
        WSA(float2, WS_ROPE)[i] = make_float2(cosf(ang), sinf(ang)); }
    for (int row = 2 * gw; row < T; row += 2 * NGW) {
        const f32x4* xr = (const f32x4*)(args.x + (size_t)row * DM) + lane;
        float s0 = 0.f, s1 = 0.f; f32x4 v[8];
#pragma unroll
        for (int j = 0; j < 8; ++j) v[j] = xr[64 * j];
#pragma unroll
        for (int j = 0; j < 4; ++j) { s0 += v[j].x * v[j].x + v[j].y * v[j].y + v[j].z * v[j].z + v[j].w * v[j].w; s1 += v[4 + j].x * v[4 + j].x + v[4 + j].y * v[4 + j].y + v[4 + j].z * v[4 + j].z + v[4 + j].w * v[4 + j].w; }
        s0 = wave_sum(s0); s1 = wave_sum(s1);
        float m0 = 0.f, m1 = 0.f;
#pragma unroll
        for (int j = 0; j < 4; ++j) { m0 = fmaxf(fmaxf(m0, fmaxf(fabsf(v[j].x), fabsf(v[j].y))), fmaxf(fabsf(v[j].z), fabsf(v[j].w))); m1 = fmaxf(fmaxf(m1, fmaxf(fabsf(v[4 + j].x), fabsf(v[4 + j].y))), fmaxf(fabsf(v[4 + j].z), fabsf(v[4 + j].w))); }
        m0 = wave_max0(m0); m1 = wave_max0(m1);
        const float i0 = m0 > 0.f ? 127.0f / m0 : 0.f, i1 = m1 > 0.f ? 127.0f / m1 : 0.f;
        { unsigned* a8 = (unsigned*)(ws + WS_Z + Z_A8 + (size_t)row * DM) + lane;
#pragma unroll
          for (int j = 0; j < 8; ++j) a8[64 * j] = q4_i8(v[j].x, v[j].y, v[j].z, v[j].w, j < 4 ? i0 : i1); }
        if (lane == 0) { WSA(float, WS_SMALL + SM_RSTD)[row] = m0 * (1.0f / 127.0f) / sqrtf(s0 * (1.0f / DM) + EPS); WSA(float, WS_SMALL + SM_RSTD)[row + 1] = m1 * (1.0f / 127.0f) / sqrtf(s1 * (1.0f / DM) + EPS); }
    }
}

constexpr int PROBE_ABL = 0;
constexpr int PROBE_PH = -1;
constexpr int PH_PRO = 0, PH_PER_LAYER = 8, PH_TOTAL = 1 + PH_PER_LAYER * DEPTH;
enum { PL_INPROJ = 0, PL_UP = 1, PL_ATTN = 2, PL_WO = 3, PL_ROUTE = 4, PL_GU = 5, PL_DOWN = 6, PL_COMB = 7 };

__global__ void __launch_bounds__(NWAVES * 64, 2) mk_fwd(MkArgs args) {
    extern __shared__ __attribute__((aligned(16))) unsigned char lds_raw[];
    LAS unsigned char* lds = (LAS unsigned char*)lds_raw;
    volatile LAS unsigned* MISC = (volatile LAS unsigned*)(lds + MISC_OFF);
    const int tid = threadIdx.x; const int wave_k = __builtin_amdgcn_readfirstlane(tid >> 6);
    const int G = gridDim.x; const int bx = blockIdx.x;
    unsigned char* const ws_k = args.ws;
    unsigned* ctl = (unsigned*)(ws_k + WS_CTL);
    for (int u = tid; u < (LDS_BYTES - RING_BYTES) / 4; u += NWAVES * 64) ((LAS unsigned*)(lds + RING_BYTES))[u] = 0u;
    __syncthreads();
    const int lo = args.ph_lo, hi = args.ph_hi;
    const bool multi = (hi - lo) > 1;
    XcdBarrier bar; bar.bar = ctl + CW_BAR; bar.x = 0; bar.st = nullptr;
    if (multi) bar = xcd_barrier_post(ctl + CW_BAR, MISC + 8);
#define PHASE_LOCALS int lane; asm volatile("v_mbcnt_lo_u32_b32 %0, -1, 0\n\tv_mbcnt_hi_u32_b32 %0, -1, %0" : "=v"(lane)); size_t zoff = 0; asm volatile("" : "+s"(zoff)); unsigned char* const ws = ws_k + zoff; int bxo = blockIdx.x; asm volatile("" : "+s"(bxo)); const int vcu = (G % 8 == 0) ? (bxo % 8) * (G / 8) + bxo / 8 : bxo
#define IN(k) (pk == (k))
#define SEAM(k) do { } while (0)
    bool probed = false;
#pragma unroll 1
    for (int ph = lo; ph < hi; ++ph) {
        if (ph == PH_PRO) { { PHASE_LOCALS; const int wave = wave_k; prologue_phase(lds, ws, args, vcu, G, wave, lane); } if (ph + 1 < hi) xcd_barrier(bar); if (PROBE_PH == 0 && !probed) { probed = true; --ph; } continue; }
        const int wave = wave_k; const bool dry = (PROBE_PH > 0 && ph == PROBE_PH && !probed);
        int l = (ph - 1) / PH_PER_LAYER; const int pk = (ph - 1) % PH_PER_LAYER; asm volatile("" : "+s"(l)); const int pb = 0;
#ifndef DBG_MASK
#define DBG_MASK 0xff
#endif
        if (((DBG_MASK >> PL_INPROJ) & 1) && IN(pb + PL_INPROJ)) {
            PHASE_LOCALS;
            pg8::DenseOrder S; S.init(ws + WS_Z + Z_A8, ws + WS_WIN + (size_t)l * IN_WP * DM, T, IN_WP, DM / 2, G, bxo); S.rot = (G == 256) ? 2 : 0;
            EpiInProj E{ws, args.b_f + l * FH, WSA(float, WS_SMALL + SM_WCS) + l * IN_WP};
            pg8::gemm_phase<EpiInProj, pg8::DenseOrder>(lds, wave, DM / 2, S, E, (dry && PROBE_ABL < 3) ? PROBE_ABL : 0);
        }
        SEAM(pb + PL_INPROJ);
        if (((DBG_MASK >> PL_UP) & 1) && IN(pb + PL_UP)) {
            PHASE_LOCALS;
            { const int sblk = (G >= 144) ? bxo - 128 : vcu; const int gw = sblk * NWAVES + wave; if (sblk >= 0 && gw < BATCH * 16) scan_tile(ws, gw, lane); }
#ifndef NO_Q
            { pg8::DenseOrder S; S.init(ws + WS_X + X_CQ, WSA(bf16_t, WS_WUQ) + (size_t)l * 768 * QL, T, 768, QL, G, bxo);
              EpiUpQ E{ws}; pg8::gemm_phase<EpiUpQ, pg8::DenseOrder>(lds, wave, QL, S, E); }
#endif
#ifndef NO_KV
            { pg8::DenseOrder S; S.init(ws + WS_X + X_CKV, WSA(bf16_t, WS_WUKV) + (size_t)l * 1024 * KVL, T, 1024, KVL, G, bxo);
              EpiUpKV E{ws}; pg8::gemm_phase<EpiUpKV, pg8::DenseOrder>(lds, wave, KVL, S, E); }
#endif
        }
        SEAM(pb + PL_UP);
        if (((DBG_MASK >> PL_ATTN) & 1) && IN(pb + PL_ATTN)) {
            PHASE_LOCALS;
            unsigned* qhead = ctl + CW_ATTQ + 64 * (dry ? 2 : l);
            if (PROBE_ABL != 0 && dry) attn_phase<PROBE_ABL>(lds, ws, qhead, wave, lane, true); else attn_phase<0>(lds, ws, qhead, wave, lane, dry);
        }
        SEAM(pb + PL_ATTN);
        if (((DBG_MASK >> PL_WO) & 1) && IN(pb + PL_WO)) {
            PHASE_LOCALS;
            pg8::DenseOrder S; S.init(ws + WS_AO, ws + WS_WO + (size_t)l * DM * DM, T, DM, DM / 2, G, bxo);
            EpiWo E{ws, l == 0 ? args.x : nullptr, WSA(float, WS_SMALL + SM_WCS2) + l * DM};
            pg8::gemm_phase<EpiWo, pg8::DenseOrder>(lds, wave, DM / 2, S, E);
        }
        SEAM(pb + PL_WO);
        if (((DBG_MASK >> PL_ROUTE) & 1) && IN(pb + PL_ROUTE)) {
            PHASE_LOCALS;
            for (int rt = vcu * NWAVES + wave; rt < T / 16; rt += G * NWAVES)   route_tile(lds, ws, args.H, ctl + CW_CNT + 2048 * (dry ? 2 : l), l, rt * 16, wave, lane, dry);
        }
        SEAM(pb + PL_ROUTE);
        if (((DBG_MASK >> PL_GU) & 1) && IN(pb + PL_GU)) {
            PHASE_LOCALS;
            moe_build_tb(lds, ctl + CW_CNT + 2048 * l, wave, lane);
            MoeOrder<2, true> S; S.tb = (LAS const int*)(lds + TB_OFF); S.A = (const char*)(ws + WS_X + X_H8); S.Bt = (const char*)(ws + WS_WGU + (size_t)l * NE * 512 * DM);
            S.list = WSA(unsigned, WS_SMALL + SM_LIST); S.K = DM / 2; S.G = G; S.c = bxo; S.bstride = (size_t)512 * DM;
            EpiGU E{ws, (LAS const int*)(lds + TB_OFF)};
            pg8::gemm_phase<EpiGU, MoeOrder<2, true>>(lds, wave, DM / 2, S, E);
        }
        SEAM(pb + PL_GU);
        if (((DBG_MASK >> PL_DOWN) & 1) && IN(pb + PL_DOWN)) {
            PHASE_LOCALS;
            moe_build_tb(lds, ctl + CW_CNT + 2048 * l, wave, lane);
            MoeOrder<4, false> S; S.tb = (LAS const int*)(lds + TB_OFF); S.A = (const char*)(ws + WS_Z + Z_HE); S.Bt = (const char*)(ws + WS_WD + (size_t)l * NE * DM * DE);
            S.list = nullptr; S.K = DE / 2; S.G = G; S.c = bxo; S.bstride = (size_t)DM * DE;
            EpiDown E{ws, (LAS const int*)(lds + TB_OFF)};
            pg8::gemm_phase<EpiDown, MoeOrder<4, false>>(lds, wave, DE / 2, S, E);
        }
        SEAM(pb + PL_DOWN);
        if (((DBG_MASK >> PL_COMB) & 1) && IN(pb + PL_COMB)) {
            PHASE_LOCALS;
            moe_build_tb(lds, ctl + CW_CNT + 2048 * l, wave, lane);
            for (int row = vcu * NWAVES + wave; row < T; row += G * NWAVES) combine_row(ws, args.H, args.final_norm, l == DEPTH - 1, row, lane, dry, (LAS const int*)(lds + TB_OFF));
        }
        SEAM(pb + PL_COMB);
        if (ph + 1 < hi) xcd_barrier(bar);
        if (PROBE_PH > 0 && ph == PROBE_PH && !probed) { probed = true; --ph; }
    }
#undef IN
#undef SEAM
}
static int g_grid = 0;
static void launch_mk(MkArgs a, int lo, int hi, hipStream_t s) { a.ph_lo = lo; a.ph_hi = hi; hipLaunchKernelGGL(mk_fwd, dim3(g_grid), dim3(NWAVES * 64), LDS_BYTES, s, a); }
extern "C" void kernel_launch(void* const* d_in, const int* in_sizes, int n_in, void* d_out, int out_size, void* d_ws, size_t ws_size, hipStream_t stream) {
    if (n_in != 19 || out_size != T * DM || ws_size < WS_END) { fprintf(stderr, "kernel_launch: unexpected shapes (n_in %d out %d ws %zu)\n", n_in, out_size, ws_size); return; }
    const float* x = (const float*)d_in[0]; const int* pos = (const int*)d_in[1];
    const float* attn_norm = (const float*)d_in[2]; const float* w_in = (const float*)d_in[3]; const float* b_f = (const float*)d_in[4];
    const float* q_norm = (const float*)d_in[5]; const float* w_uq = (const float*)d_in[6]; const float* kv_norm = (const float*)d_in[7]; const float* w_ukv = (const float*)d_in[8];
    const float* fox_on = (const float*)d_in[9]; const float* mla_on = (const float*)d_in[10]; const float* w_o = (const float*)d_in[11];
    const float* ffn_norm = (const float*)d_in[12]; const float* w_group = (const float*)d_in[13]; const float* w_router = (const float*)d_in[14];
    const float* w_gate = (const float*)d_in[15]; const float* w_up = (const float*)d_in[16]; const float* w_down = (const float*)d_in[17]; const float* final_norm = (const float*)d_in[18];
    unsigned char* ws = (unsigned char*)d_ws;
    if (g_grid == 0) {
        int dev = 0, cus = 0;
        if (hipGetDevice(&dev) != hipSuccess || hipDeviceGetAttribute(&cus, hipDeviceAttributeMultiprocessorCount, dev) != hipSuccess) { fprintf(stderr, "kernel_launch: device query failed\n"); return; }
        if (hipFuncSetAttribute((const void*)mk_fwd, hipFuncAttributeMaxDynamicSharedMemorySize, LDS_BYTES) != hipSuccess) { fprintf(stderr, "kernel_launch: hipFuncSetAttribute failed\n"); return; }
        g_grid = cus;
    }
    (void)hipMemsetAsync(ws + WS_CTL, 0, 65536, stream);
    MkArgs ma{}; ma.x = x; ma.pos = pos; ma.b_f = b_f; ma.final_norm = final_norm; for (int i = 0; i < 19; ++i) ma.in[i] = (const float*)d_in[i]; ma.H = (float*)d_out; ma.ws = ws;
    launch_mk(ma, 0, PH_TOTAL, stream);
}
```

```cpp
#include <hip/hip_runtime.h>
#include <cstdio>
#include <cstdint>
#include <cmath>

typedef unsigned short bf16_t;
typedef unsigned u32x4 __attribute__((ext_vector_type(4)));
typedef float f32x4 __attribute__((ext_vector_type(4)));

constexpr int BATCH = 8, SEQ = 4096, T = BATCH * SEQ, DM = 1024, DEPTH = 2;
constexpr int FH = 8, FD = 64, FW = 512;
constexpr int MH = 8, NOPE = 64, ROPE = 32, MDK = 96, MV = 64, MW = 512;
constexpr int QL = 256, KVL = 128;
constexpr int IN_W = 1960, IN_WP = 2048;
constexpr int NG = 8, EPG = 4, NE = 32, DE = 256;
constexpr int APAD = 73728;
constexpr float EPS = 1e-6f;
constexpr float LOG2E = 1.4426950408889634f;
constexpr float C2F = 0.125f * LOG2E;
constexpr float C2M = 0.10206207261596575f * LOG2E;
constexpr int RW = 48;

constexpr size_t MiB = 1u << 20;
constexpr size_t WS_CTL = 0;
constexpr size_t WS_WIN = 1 * MiB;
constexpr size_t WS_WUQ = 9 * MiB;
constexpr size_t WS_WUKV = 10 * MiB;
constexpr size_t WS_WR = 11 * MiB;
constexpr size_t WS_WO = 12 * MiB;
constexpr size_t WS_WGU = 16 * MiB;
constexpr size_t WS_WD = 80 * MiB;
constexpr size_t WS_ROPE = 112 * MiB;
constexpr size_t WS_SMALL = 116 * MiB;
constexpr size_t WS_HB = 124 * MiB;
constexpr size_t WS_X = 188 * MiB;
constexpr size_t WS_Z = 316 * MiB;
constexpr size_t WS_AO = 444 * MiB;
constexpr size_t WS_END = 508 * MiB;
constexpr size_t SM_RSTD = 0;
constexpr size_t SM_RSTD2 = 128 * 1024;
constexpr size_t SM_SSQQ = 256 * 1024;
constexpr size_t SM_SSQKV = 768 * 1024;
constexpr size_t SM_LF = 1280 * 1024;
constexpr size_t SM_D = 2304 * 1024;
constexpr size_t SM_GATE = 3328 * 1024;
constexpr size_t SM_LIST = 3584 * 1024;
constexpr size_t SM_TSLOT = 7680 * 1024;
constexpr size_t X_FQ = 0, X_FK = 32 * MiB, X_FV = 64 * MiB, X_CQ = 96 * MiB, X_CKV = 112 * MiB, X_KR = 120 * MiB;
constexpr size_t X_Y0 = 0, X_Y1 = 64 * MiB;
constexpr size_t X_YT = 0;
constexpr size_t Z_QM = 0, Z_KM = 48 * MiB, Z_KR = 80 * MiB, Z_VM = 96 * MiB;
constexpr size_t Z_HE = 0;
constexpr int CW_CNT = 8192;

__device__ __forceinline__ unsigned f2bf(float f) { unsigned u = __builtin_bit_cast(unsigned, f); return (u + 0x7fffu + ((u >> 16) & 1u)) >> 16; }
__device__ __forceinline__ float bf2f(unsigned h) { return __builtin_bit_cast(float, h << 16); }
__device__ __forceinline__ unsigned pk2(float lo, float hi) { return f2bf(lo) | (f2bf(hi) << 16); }
__device__ __forceinline__ float xadd32(float v) { const unsigned a = __builtin_bit_cast(unsigned, v); auto r = __builtin_amdgcn_permlane32_swap(a, a, false, false); const unsigned x = r[0], y = r[1]; return __builtin_bit_cast(float, x) + __builtin_bit_cast(float, y); }
__device__ __forceinline__ float xadd16(float v) { const unsigned a = __builtin_bit_cast(unsigned, v); auto r = __builtin_amdgcn_permlane16_swap(a, a, false, false); const unsigned x = r[0], y = r[1]; return __builtin_bit_cast(float, x) + __builtin_bit_cast(float, y); }
__device__ __forceinline__ float xchg32(float v, bool lower_half) { const unsigned a = __builtin_bit_cast(unsigned, v); auto r = __builtin_amdgcn_permlane32_swap(a, a, false, false); const unsigned x = r[0], y = r[1]; return __builtin_bit_cast(float, lower_half ? y : x); }
template <int CTRL> __device__ __forceinline__ float dppf(float v) { return __builtin_bit_cast(float, __builtin_amdgcn_update_dpp(0u, __builtin_bit_cast(unsigned, v), CTRL, 0xf, 0xf, true)); }
__device__ __forceinline__ float wave_sum(float v) {
    v += dppf<0xB1>(v); v += dppf<0x4E>(v); v += dppf<0x141>(v); v += dppf<0x140>(v);
    v = xadd16(v); v = xadd32(v);
    return v;
}
__device__ __forceinline__ float dot_bf16(const bf16_t* a, const bf16_t* b, int K) {
    float acc = 0.f;
    for (int k = 0; k < K; k += 8) {
        const u32x4 va = *(const u32x4*)(a + k), vb = *(const u32x4*)(b + k);
#pragma unroll
        for (int j = 0; j < 4; ++j) {
            acc += bf2f(va[j] & 0xffffu) * bf2f(vb[j] & 0xffffu);
            acc += bf2f(va[j] >> 16) * bf2f(vb[j] >> 16);
        }
    }
    return acc;
}

__device__ __forceinline__ int map_in(int n) {
    if (n < 1536) return n;
    if (n < 1792) return 1544 + (n - 1536);
    if (n < 1920) return 1800 + (n - 1792);
    if (n < 1952) return 1928 + (n - 1920);
    if (n < 1960) return 1536 + (n - 1952);
    return -1;
}
__device__ __forceinline__ int map_uq(int n) { return n < 512 ? (n >> 6) * 96 + (n & 63) : ((n - 512) >> 5) * 96 + 64 + ((n - 512) & 31); }
__device__ __forceinline__ int map_ukv(int n) { return n < 512 ? (n >> 6) * 128 + (n & 63) : ((n - 512) >> 6) * 128 + 64 + ((n - 512) & 63); }
__device__ __forceinline__ int map_id(int n) { return n; }

#define LAS __attribute__((address_space(3)))
#define GAS __attribute__((address_space(1)))
typedef short bf16x8 __attribute__((ext_vector_type(8)));
typedef float f32x2 __attribute__((ext_vector_type(2)));
typedef float f32x16 __attribute__((ext_vector_type(16)));
typedef unsigned u32x2 __attribute__((ext_vector_type(2)));
typedef int i32x4 __attribute__((ext_vector_type(4)));
typedef int i32x8 __attribute__((ext_vector_type(8)));
typedef long i64x2 __attribute__((ext_vector_type(2)));
constexpr size_t X_H8 = 96 * MiB;
constexpr float F8_WGU = 64.0f, F8_WD = 32.0f;
constexpr size_t Z_A8 = 48 * MiB;
constexpr size_t SM_WCS = 7936 * 1024;
__device__ __forceinline__ float xmx32(float v) { const unsigned a = __builtin_bit_cast(unsigned, v); auto r = __builtin_amdgcn_permlane32_swap(a, a, false, false); const unsigned x = r[0], y = r[1]; return fmaxf(__builtin_bit_cast(float, x), __builtin_bit_cast(float, y)); }
__device__ __forceinline__ float xmx16(float v) { const unsigned a = __builtin_bit_cast(unsigned, v); auto r = __builtin_amdgcn_permlane16_swap(a, a, false, false); const unsigned x = r[0], y = r[1]; return fmaxf(__builtin_bit_cast(float, x), __builtin_bit_cast(float, y)); }
__device__ __forceinline__ float wave_max0(float v) {
    v = fmaxf(v, dppf<0xB1>(v)); v = fmaxf(v, dppf<0x4E>(v)); v = fmaxf(v, dppf<0x141>(v)); v = fmaxf(v, dppf<0x140>(v)); v = xmx16(v); v = xmx32(v); return v; }
constexpr float AO_C = 6.0f;
constexpr size_t SM_WCS2 = SM_WCS + 16384;
__device__ __forceinline__ unsigned q4_i8c(float a, float b, float c, float d, float inv) {
    const int q0 = (int)__builtin_rintf(__builtin_amdgcn_fmed3f(a * inv, -127.f, 127.f)), q1 = (int)__builtin_rintf(__builtin_amdgcn_fmed3f(b * inv, -127.f, 127.f));
    const int q2 = (int)__builtin_rintf(__builtin_amdgcn_fmed3f(c * inv, -127.f, 127.f)), q3 = (int)__builtin_rintf(__builtin_amdgcn_fmed3f(d * inv, -127.f, 127.f));
    return ((unsigned)q0 & 0xffu) | (((unsigned)q1 & 0xffu) << 8) | (((unsigned)q2 & 0xffu) << 16) | ((unsigned)q3 << 24); }
__device__ __forceinline__ unsigned q4_i8(float a, float b, float c, float d, float inv) {
    const int q0 = (int)__builtin_rintf(a * inv), q1 = (int)__builtin_rintf(b * inv), q2 = (int)__builtin_rintf(c * inv), q3 = (int)__builtin_rintf(d * inv);
    return ((unsigned)q0 & 0xffu) | (((unsigned)q1 & 0xffu) << 8) | (((unsigned)q2 & 0xffu) << 16) | ((unsigned)q3 << 24); }
constexpr int NWAVES = 8;
constexpr int RING_BYTES = 131072;
constexpr int MISC_OFF = RING_BYTES + 320;
constexpr int TB_OFF = RING_BYTES + 1024;
constexpr int LDS_BYTES = 147456;

constexpr size_t X_QA = 120 * MiB, X_KA = 124 * MiB;
namespace pg8 {
constexpr int BM = 256, BK = 64, HALF = 128, HTB = HALF * BK * 2, NXCD = 8, WGM = 8;
__device__ __forceinline__ int lds_byte(int r, int c) { const int st = (r >> 4) * 2 + (c >> 5), rr = r & 15, cc = c & 31, ob = rr * 64 + cc * 2; return st * 1024 + (ob ^ (((ob >> 9) & 1) << 5)); }
__device__ __forceinline__ void stage_rc(int b, int& R, int& C) { const int st = b / 1024, sb = b % 1024, swz = sb ^ (((sb >> 9) & 1) << 5); R = (st >> 1) * 16 + swz / 64; C = (st & 1) * 32 + (swz % 64) / 2; }
__device__ __forceinline__ int perm32(int rho) { const int n = rho >> 4, i = rho & 15; return 8 * (i >> 2) + 4 * n + (i & 3); }
__device__ __forceinline__ unsigned cvt_pk_bf16(float lo, float hi) { unsigned r; asm volatile("v_cvt_pk_bf16_f32 %0, %1, %2" : "=v"(r) : "v"(lo), "v"(hi)); return r; }

struct Unit { int pm, pn, e, tile; const char* A; const char* B; };
struct LaneRC { int R[2], C[2]; };

struct DenseOrder {
    static constexpr bool GATHER = false;
    __device__ __forceinline__ void lane_offs(const Unit&, const LaneRC&, unsigned (&)[2], unsigned (&)[2]) const {}
    const char* A; const char* Bt; int K, nM, nN, nwg, G, c, rot;
    __device__ __forceinline__ void init(const void* A_, const void* Bt_, int M, int N, int K_, int G_, int c_) { A = (const char*)A_; Bt = (const char*)Bt_; K = K_; nM = M / BM; nN = N / BM; nwg = nM * nN; G = G_; c = c_; rot = 0; }
    __device__ __forceinline__ bool next(int i, Unit& u) const {
        const long L = (long)i * G + c; if (L >= nwg) return false;
        int wgid = (int)L; { const int q = nwg / NXCD, r = nwg % NXCD, xcd = wgid % NXCD, off = wgid / NXCD; wgid = (xcd < r ? xcd * (q + 1) : r * (q + 1) + (xcd - r) * q) + off; }
        const int nig = WGM * nN, gid = wgid / nig, fm = gid * WGM, gsz = (nM - fm) < WGM ? (nM - fm) : WGM;
        u.pm = fm + ((wgid % nig) % gsz); u.pn = (wgid % nig) / gsz; u.e = 0; u.tile = 0;
        if (rot != 0 && (i & 2)) u.pn = (u.pn + rot) % nN;
        u.A = A + (size_t)u.pm * BM * K * 2; u.B = Bt + (size_t)u.pn * BM * K * 2;
        return true;
    }
};

template <class Epi, class Sched>
__device__ __forceinline__ void gemm_phase(LAS unsigned char* lds, const int wave_in, const int K_in, const Sched& S, const Epi& E, const int gabl = 0) {
    int K_ = K_in; asm volatile("" : "+s"(K_)); const int K = K_;
    int wave_o = wave_in; asm volatile("" : "+s"(wave_o));
    int tid_; asm volatile("v_mbcnt_lo_u32_b32 %0, -1, 0\n\tv_mbcnt_hi_u32_b32 %0, -1, %0" : "=v"(tid_)); tid_ += 64 * wave_o;
    const int tid = tid_, wid = wave_o, lane = tid & 63, wr = wid >> 2, wc = wid & 3, fr = lane & 15, fq = lane >> 4;
    const int nt = K / BK;
    LaneRC rc; unsigned voffA[2], voffB[2]; constexpr bool GA = Sched::GATHER;
#pragma unroll
    for (int i = 0; i < 2; ++i) { int R, C; stage_rc(tid * 16 + i * 8192, R, C); rc.R[i] = R; rc.C[i] = C; const int Rb = Epi::PERM ? ((R & ~31) + perm32(R & 31)) : R; voffA[i] = (unsigned)(R * K + C) * 2u; voffB[i] = (unsigned)(Rb * K + C) * 2u; }
    const size_t kstep = (size_t)(BK * 2);
    const size_t hstep = (size_t)HALF * K * 2;
    const unsigned ldsw = (unsigned)wid * 1024u;
    const int aoff = lds_byte(wr * 64 + fr, fq * 8), boff = lds_byte(wc * 32 + fr, fq * 8);
#define PG8_SA(b, h) (((b) * 2 + (h)) * HTB)
#define PG8_SB(b, h) ((4 + (b) * 2 + (h)) * HTB)
#define PG8_STAGE(bufoff, gbase, voff) do { _Pragma("unroll") for (int _i = 0; _i < 2; ++_i) \
        __builtin_amdgcn_global_load_lds((const unsigned*)((const char*)(gbase) + (voff)[_i]), (LAS unsigned*)(lds + (bufoff) + ldsw + _i * 8192), 16, 0, 0); } while (0)
#define PG8_LDA(dst, b, h) do { _Pragma("unroll") for (int m = 0; m < 4; ++m) _Pragma("unroll") for (int k = 0; k < 2; ++k) dst[m][k] = *(const LAS bf16x8*)(lds + PG8_SA(b, h) + aoff + m * 2048 + k * 1024); } while (0)
#define PG8_LDB(dst, b, h) do { _Pragma("unroll") for (int n = 0; n < 2; ++n) _Pragma("unroll") for (int k = 0; k < 2; ++k) dst[n][k] = *(const LAS bf16x8*)(lds + PG8_SB(b, h) + boff + n * 2048 + k * 1024); } while (0)
    unsigned f8one = 0x7f7f7f7fu; asm volatile("" : "+v"(f8one));
#define PG8_MMA(ai, bj, At, Bt) do { if (gabl == 2) { asm volatile("" :: "v"(At[0][0]), "v"(At[3][1]), "v"(Bt[0][0]), "v"(Bt[1][1])); break; } __builtin_amdgcn_s_setprio(1); \
        if constexpr (Epi::F8) { _Pragma("unroll") for (int m = 0; m < 4; ++m) _Pragma("unroll") for (int n = 0; n < 2; ++n) { \
            const i32x8 b_ = __builtin_shufflevector(__builtin_bit_cast(i32x4, Bt[n][0]), __builtin_bit_cast(i32x4, Bt[n][1]), 0, 1, 2, 3, 4, 5, 6, 7); \
            const i32x8 a_ = __builtin_shufflevector(__builtin_bit_cast(i32x4, At[m][0]), __builtin_bit_cast(i32x4, At[m][1]), 0, 1, 2, 3, 4, 5, 6, 7); \
            asm volatile("v_mfma_scale_f32_16x16x128_f8f6f4 %0, %1, %2, %0, %3, %3 op_sel_hi:[0,0,0]" : "+v"(acc[ai][bj][m][n]) : "v"(b_), "v"(a_), "v"(f8one)); } } \
        else if constexpr (Epi::I8) { _Pragma("unroll") for (int m = 0; m < 4; ++m) _Pragma("unroll") for (int n = 0; n < 2; ++n) _Pragma("unroll") for (int k = 0; k < 2; ++k) \
        acc[ai][bj][m][n] = __builtin_bit_cast(f32x4, __builtin_amdgcn_mfma_i32_16x16x64_i8(__builtin_bit_cast(i32x4, Bt[n][k]), __builtin_bit_cast(i32x4, At[m][k]), __builtin_bit_cast(i32x4, acc[ai][bj][m][n]), 0, 0, 0)); } \
        else { _Pragma("unroll") for (int m = 0; m < 4; ++m) _Pragma("unroll") for (int n = 0; n < 2; ++n) _Pragma("unroll") for (int k = 0; k < 2; ++k) \
        acc[ai][bj][m][n] = __builtin_amdgcn_mfma_f32_16x16x32_bf16(Bt[n][k], At[m][k], acc[ai][bj][m][n], 0, 0, 0); } __builtin_amdgcn_s_setprio(0); } while (0)
#define PG8_WAIT_V(n) asm volatile("s_waitcnt vmcnt(" #n ")" ::: "memory")
#define PG8_WAIT_L(n) asm volatile("s_waitcnt lgkmcnt(" #n ")" ::: "memory")
#define PG8_BAR __builtin_amdgcn_s_barrier()
#define PG8_SCHED __builtin_amdgcn_sched_barrier(0)
#define PG8_STAGE_A(bufoff, base, h, V0, V1) do { if constexpr (GA) { if (h) PG8_STAGE(bufoff, base, V1); else PG8_STAGE(bufoff, base, V0); } else { PG8_STAGE(bufoff, (base) + ((h) ? hstep : 0), voffA); } } while (0)
    Unit cur, nxt; int ui = 0;
    unsigned cv0[2] = {0u, 0u}, cv1[2] = {0u, 0u}, nv0[2] = {0u, 0u}, nv1[2] = {0u, 0u};
    if (!S.next(0, cur)) return;
    S.lane_offs(cur, rc, cv0, cv1);
    f32x4 acc[2][2][4][2];
#pragma unroll
    for (int a = 0; a < 2; ++a)
#pragma unroll
        for (int b = 0; b < 2; ++b)
#pragma unroll
            for (int m = 0; m < 4; ++m)
#pragma unroll
                for (int n = 0; n < 2; ++n) acc[a][b][m][n] = (f32x4){0.f, 0.f, 0.f, 0.f};
    bf16x8 At[4][2], B0[2][2], B1[2][2];
    const char* cA = cur.A; const char* cB = cur.B;
    PG8_STAGE(PG8_SB(0, 0), cB, voffB); PG8_STAGE(PG8_SB(0, 1), cB + hstep, voffB); PG8_STAGE_A(PG8_SA(0, 0), cA, 0, cv0, cv1); PG8_STAGE_A(PG8_SA(0, 1), cA, 1, cv0, cv1);
    if (wr == 1) PG8_BAR;
    PG8_WAIT_V(2); PG8_BAR;
    PG8_STAGE(PG8_SB(1, 0), cB + kstep, voffB); PG8_STAGE_A(PG8_SA(1, 0), cA + kstep, 0, cv0, cv1); PG8_STAGE(PG8_SB(1, 1), cB + hstep + kstep, voffB);
    PG8_WAIT_V(6); PG8_BAR;
    for (;;) {
        const bool has_next = S.next(ui + 1, nxt);
        if (!has_next) nxt = cur;
        if constexpr (GA) { if (has_next) S.lane_offs(nxt, rc, nv0, nv1); else { nv0[0] = cv0[0]; nv0[1] = cv0[1]; nv1[0] = cv1[0]; nv1[1] = cv1[1]; } }
        const char* nA = nxt.A; const char* nB = nxt.B;
#pragma unroll 1
        for (int t = 0; t < nt; t += 2) {
            const bool last = (t == nt - 2);
            const char* a1 = cA + (size_t)(t + 1) * kstep;
            const char* a2 = last ? nA : cA + (size_t)(t + 2) * kstep; const char* b2 = last ? nB : cB + (size_t)(t + 2) * kstep;
            const char* a3 = a2 + kstep; const char* b3 = b2 + kstep;
            unsigned x0[2], x1[2];
#pragma unroll
            for (int i = 0; i < 2; ++i) { x0[i] = last ? nv0[i] : cv0[i]; x1[i] = last ? nv1[i] : cv1[i]; }
            PG8_LDB(B0, 0, 0); PG8_LDB(B1, 0, 1); PG8_SCHED; PG8_LDA(At, 0, 0); PG8_STAGE_A(PG8_SA(1, 1), a1, 1, cv0, cv1);
            PG8_WAIT_V(8); PG8_WAIT_L(0); PG8_BAR; PG8_MMA(0, 0, At, B0); PG8_MMA(0, 1, At, B1); PG8_BAR; PG8_SCHED;
            PG8_LDA(At, 0, 1); PG8_STAGE(PG8_SB(0, 0), b2, voffB); PG8_STAGE(PG8_SB(0, 1), b2 + hstep, voffB); PG8_STAGE_A(PG8_SA(0, 0), a2, 0, x0, x1);
            PG8_WAIT_V(8); PG8_WAIT_L(0); PG8_BAR; PG8_MMA(1, 0, At, B0); PG8_MMA(1, 1, At, B1); PG8_BAR; PG8_SCHED;
            PG8_LDB(B0, 1, 0); PG8_LDB(B1, 1, 1); PG8_SCHED; PG8_LDA(At, 1, 0); PG8_STAGE_A(PG8_SA(0, 1), a2, 1, x0, x1);
            PG8_WAIT_V(8); PG8_WAIT_L(0); PG8_BAR; PG8_MMA(0, 0, At, B0); PG8_MMA(0, 1, At, B1); PG8_BAR; PG8_SCHED;
            PG8_LDA(At, 1, 1); PG8_STAGE(PG8_SB(1, 0), b3, voffB); PG8_STAGE(PG8_SB(1, 1), b3 + hstep, voffB); PG8_STAGE_A(PG8_SA(1, 0), a3, 0, x0, x1);
            PG8_WAIT_V(8); PG8_WAIT_L(0); PG8_BAR; PG8_MMA(1, 0, At, B0); PG8_MMA(1, 1, At, B1); PG8_BAR; PG8_SCHED;
        }
        if (wr == 0) PG8_BAR;
        if (gabl != 0) { _Pragma("unroll") for (int a = 0; a < 2; ++a) _Pragma("unroll") for (int b = 0; b < 2; ++b) _Pragma("unroll") for (int m = 0; m < 4; ++m) _Pragma("unroll") for (int n = 0; n < 2; ++n) asm volatile("" :: "v"(acc[a][b][m][n])); }
        else { if constexpr (Epi::F8) asm volatile("s_nop 15\n\ts_nop 15\n\ts_nop 15" ::: "memory");
          int fr_e = fr, fq_e = fq; asm volatile("" : "+v"(fr_e), "+v"(fq_e));
          E(acc, cur, wr, wc, fr_e, fq_e); }
        if (!has_next) break;
#pragma unroll
        for (int a = 0; a < 2; ++a)
#pragma unroll
            for (int b = 0; b < 2; ++b)
#pragma unroll
                for (int m = 0; m < 4; ++m)
#pragma unroll
                    for (int n = 0; n < 2; ++n) acc[a][b][m][n] = (f32x4){0.f, 0.f, 0.f, 0.f};
        cur = nxt; cA = nA; cB = nB; ++ui;
        if constexpr (GA) { cv0[0] = nv0[0]; cv0[1] = nv0[1]; cv1[0] = nv1[0]; cv1[1] = nv1[1]; }
        if (wr == 1) PG8_BAR;
    }
    PG8_WAIT_V(0);
    PG8_BAR;
#undef PG8_SA
#undef PG8_SB
#undef PG8_STAGE
#undef PG8_STAGE_A
#undef PG8_LDA
#undef PG8_LDB
#undef PG8_MMA
#undef PG8_WAIT_V
#undef PG8_WAIT_L
#undef PG8_BAR
#undef PG8_SCHED
}
}

struct MkArgs {
    const float* x; const int* pos; const float* b_f; const float* final_norm; const float* in[19];
    float* H; unsigned char* ws;
    int ph_lo, ph_hi;
};
#define WSA(type, off) ((type*)(ws + (off)))

typedef f32x4 Acc[2][2][4][2];
__device__ __forceinline__ u32x4 pack8(const f32x4 a, const f32x4 b, float s) {
    u32x4 w; w.x = pg8::cvt_pk_bf16(a[0] * s, a[1] * s); w.y = pg8::cvt_pk_bf16(a[2] * s, a[3] * s); w.z = pg8::cvt_pk_bf16(b[0] * s, b[1] * s); w.w = pg8::cvt_pk_bf16(b[2] * s, b[3] * s); return w;
}
__device__ __forceinline__ float sq8(const f32x4 a, const f32x4 b) { return (a[0] * a[0] + a[1] * a[1]) + (a[2] * a[2] + a[3] * a[3]) + (b[0] * b[0] + b[1] * b[1]) + (b[2] * b[2] + b[3] * b[3]); }
__device__ __forceinline__ void rotary8(f32x4& v0, f32x4& v1, const float2* cs8, int fq) {
    f32x4 p0, p1;
#pragma unroll
    for (int j = 0; j < 4; ++j) { p0[j] = xchg32(v0[j], fq < 2); p1[j] = xchg32(v1[j], fq < 2); }
    const float sg = fq < 2 ? -1.f : 1.f;
#pragma unroll
    for (int j = 0; j < 4; ++j) { const float2 c0 = cs8[j], c1 = cs8[4 + j]; v0[j] = v0[j] * c0.x + sg * p0[j] * c0.y; v1[j] = v1[j] * c1.x + sg * p1[j] * c1.y; }
}

__device__ __forceinline__ void ld8_rows_f32x4(f32x4 (&v)[8], const float* p) {
    asm volatile("global_load_dwordx4 %0, %8, off\n\tglobal_load_dwordx4 %1, %8, off offset:256\n\tglobal_load_dwordx4 %2, %8, off offset:512\n\tglobal_load_dwordx4 %3, %8, off offset:768\n\t"
                 "global_load_dwordx4 %4, %8, off offset:2048\n\tglobal_load_dwordx4 %5, %8, off offset:2304\n\tglobal_load_dwordx4 %6, %8, off offset:2560\n\tglobal_load_dwordx4 %7, %8, off offset:2816\n\ts_waitcnt vmcnt(0)"
                 : "=&v"(v[0]), "=&v"(v[1]), "=&v"(v[2]), "=&v"(v[3]), "=&v"(v[4]), "=&v"(v[5]), "=&v"(v[6]), "=&v"(v[7]) : "v"(p) : "memory");
}

struct EpiInProj {
    static constexpr bool PERM = true; static constexpr bool F8 = false; static constexpr bool I8 = true;
    unsigned char* ws; const float* b_f; const float* wcs;
    __device__ __forceinline__ void operator()(Acc& acc, const pg8::Unit& u, int wr, int wc, int fr, int fq) const {
        const int row0 = u.pm * 256 + wr * 64 + fr, pn = u.pn;
        { const float* cp = wcs + pn * 256 + wc * 32 + 8 * fq;
          const f32x4 c00 = *(const f32x4*)(cp), c01 = *(const f32x4*)(cp + 4), c10 = *(const f32x4*)(cp + 128), c11 = *(const f32x4*)(cp + 132);
#pragma unroll
          for (int ai = 0; ai < 2; ++ai)
#pragma unroll
              for (int m = 0; m < 4; ++m) {
                  acc[ai][0][m][0] = __builtin_convertvector(__builtin_bit_cast(i32x4, acc[ai][0][m][0]), f32x4) * c00; acc[ai][0][m][1] = __builtin_convertvector(__builtin_bit_cast(i32x4, acc[ai][0][m][1]), f32x4) * c01;
                  acc[ai][1][m][0] = __builtin_convertvector(__builtin_bit_cast(i32x4, acc[ai][1][m][0]), f32x4) * c10; acc[ai][1][m][1] = __builtin_convertvector(__builtin_bit_cast(i32x4, acc[ai][1][m][1]), f32x4) * c11; } }
        const float* rstd = WSA(float, WS_SMALL + SM_RSTD);
        float rsv[8];
#pragma unroll
        for (int i = 0; i < 8; ++i) rsv[i] = rstd[row0 + (i >> 2) * 128 + (i & 3) * 16];
        if (pn < 6) {
            bf16_t* base0 = WSA(bf16_t, WS_X + (size_t)(pn >> 1) * 32 * MiB) + (pn & 1) * 256 + wc * 32 + 8 * fq;
            float nmx0 = 0.f, nmx1 = 0.f;
#pragma unroll
            for (int ai = 0; ai < 2; ++ai)
#pragma unroll
                for (int m = 0; m < 4; ++m) {
                    const int row = row0 + ai * 128 + m * 16; const float sc = pn < 2 ? rsv[ai * 4 + m] * C2F : rsv[ai * 4 + m];
                    bf16_t* base = base0 + (size_t)row * 512;
                    *(u32x4*)(base) = pack8(acc[ai][0][m][0], acc[ai][0][m][1], sc); *(u32x4*)(base + 128) = pack8(acc[ai][1][m][0], acc[ai][1][m][1], sc);
                    if (pn < 4) { float s0 = sq8(acc[ai][0][m][0], acc[ai][0][m][1]) * sc * sc, s1 = sq8(acc[ai][1][m][0], acc[ai][1][m][1]) * sc * sc;
                        s0 = xadd16(s0); s0 = xadd32(s0); s1 = xadd16(s1); s1 = xadd32(s1); nmx0 = fmaxf(nmx0, s0); nmx1 = fmaxf(nmx1, s1); }
                }
            if (pn < 4) {
                nmx0 = fmaxf(nmx0, dppf<0xB1>(nmx0)); nmx0 = fmaxf(nmx0, dppf<0x4E>(nmx0)); nmx0 = fmaxf(nmx0, dppf<0x141>(nmx0)); nmx0 = fmaxf(nmx0, dppf<0x140>(nmx0));
                nmx1 = fmaxf(nmx1, dppf<0xB1>(nmx1)); nmx1 = fmaxf(nmx1, dppf<0x4E>(nmx1)); nmx1 = fmaxf(nmx1, dppf<0x141>(nmx1)); nmx1 = fmaxf(nmx1, dppf<0x140>(nmx1));
                if (fq == 0 && fr == 0) { float* tm = WSA(float, WS_SMALL + SM_D + 65536) + ((((size_t)(pn >> 1) * 128 + u.pm) * 8 + (pn & 1) * 4 + (wc >> 1)) * 2 + (wc & 1)) * 2 + wr;
                    tm[0] = nmx0; tm[8] = nmx1; }
            }
        } else if (pn == 6) {
#pragma unroll
            for (int ai = 0; ai < 2; ++ai)
#pragma unroll
                for (int m = 0; m < 4; ++m) {
                    const int row = row0 + ai * 128 + m * 16; const float rs = rsv[ai * 4 + m];
                    bf16_t* base = WSA(bf16_t, WS_X + X_CQ) + (size_t)row * QL + wc * 32 + 8 * fq;
                    *(u32x4*)(base) = pack8(acc[ai][0][m][0], acc[ai][0][m][1], rs); *(u32x4*)(base + 128) = pack8(acc[ai][1][m][0], acc[ai][1][m][1], rs);
                    float s = (sq8(acc[ai][0][m][0], acc[ai][0][m][1]) + sq8(acc[ai][1][m][0], acc[ai][1][m][1])) * rs * rs; s = xadd16(s); s = xadd32(s);
                    if (fq == 0) WSA(float, WS_SMALL + SM_SSQQ)[row * 4 + wc] = s;
                }
        } else {
            f32x4 lfs0 = {0.f, 0.f, 0.f, 0.f}, lfs1 = lfs0;
#pragma unroll
            for (int ai = 0; ai < 2; ++ai)
#pragma unroll
                for (int m = 0; m < 4; ++m) {
                    const int row = row0 + ai * 128 + m * 16; const float rs = rsv[ai * 4 + m];
                    *(u32x4*)(WSA(bf16_t, WS_X + X_CKV) + (size_t)row * KVL + wc * 32 + 8 * fq) = pack8(acc[ai][0][m][0], acc[ai][0][m][1], rs);
                    float s = sq8(acc[ai][0][m][0], acc[ai][0][m][1]) * rs * rs; s = xadd16(s); s = xadd32(s);
                    if (fq == 0) WSA(float, WS_SMALL + SM_SSQKV)[row * 4 + wc] = s;
                    if (wc == 0) {
                        f32x4 v0 = acc[ai][1][m][0] * rs, v1 = acc[ai][1][m][1] * rs;
                        float2 cs8[8]; const float2* cp = WSA(float2, WS_ROPE) + (size_t)row * 16 + 8 * (fq & 1);
#pragma unroll
                        for (int j = 0; j < 8; ++j) cs8[j] = cp[j];
                        rotary8(v0, v1, cs8, fq);
                        const u32x4 w = pack8(v0, v1, 1.f);
                        *(u32x4*)(WSA(bf16_t, WS_Z + Z_KR) + (size_t)row * ROPE + 8 * fq) = w;
                    } else if (wc == 1 && fq == 0) {
                        f32x4 o[2];
#pragma unroll
                        for (int n = 0; n < 2; ++n)
#pragma unroll
                            for (int j = 0; j < 4; ++j) { const float z = acc[ai][1][m][n][j] * rs + b_f[4 * n + j];
                                o[n][j] = fminf(z, 0.f) - 0.6931471805599453f * __builtin_amdgcn_logf(1.0f + __builtin_amdgcn_exp2f(-1.4426950408889634f * fabsf(z))); }
                        f32x4* lf = (f32x4*)(WSA(float, WS_SMALL + SM_LF) + (size_t)row * 8); lf[0] = o[0]; lf[1] = o[1];
                        lfs0 += o[0]; lfs1 += o[1];
                    }
                }
            if (wc == 1) {
#pragma unroll
                for (int j = 0; j < 4; ++j) { float a = lfs0[j], bq = lfs1[j];
                    a += dppf<0xB1>(a); a += dppf<0x4E>(a); a += dppf<0x141>(a); a += dppf<0x140>(a);
                    bq += dppf<0xB1>(bq); bq += dppf<0x4E>(bq); bq += dppf<0x141>(bq); bq += dppf<0x140>(bq);
                    lfs0[j] = a; lfs1[j] = bq; }
                if (fq == 0 && fr == 0) { f32x4* ts = (f32x4*)(WSA(float, WS_SMALL + SM_D) + ((size_t)u.pm * 2 + wr) * 8); ts[0] = lfs0; ts[1] = lfs1; }
            }
        }
    }
};
struct EpiUpQ {
    static constexpr bool PERM = true; static constexpr bool F8 = false; static constexpr bool I8 = false;
    unsigned char* ws;
    __device__ __forceinline__ void operator()(const Acc& acc, const pg8::Unit& u, int wr, int wc, int fr, int fq) const {
        const int row0 = u.pm * 256 + wr * 64 + fr, pn = u.pn;
        float rsv[8];
#pragma unroll
        for (int i = 0; i < 8; ++i) rsv[i] = 0.f;
        { f32x4 sp[8]; ld8_rows_f32x4(sp, WSA(float, WS_SMALL + SM_SSQQ) + (size_t)row0 * 4);
#pragma unroll
          for (int i = 0; i < 8; ++i) rsv[i] = ((sp[i][0] + sp[i][1]) + (sp[i][2] + sp[i][3])) * (1.0f / QL) + EPS; }
        if (pn < 2) {
            const int c0 = pn * 256 + wc * 32 + 8 * fq, c1 = c0 + 128;
            bf16_t* q0 = WSA(bf16_t, WS_Z + Z_QM) + (c0 >> 6) * MDK + (c0 & 63); bf16_t* q1 = WSA(bf16_t, WS_Z + Z_QM) + (c1 >> 6) * MDK + (c1 & 63);
#pragma unroll
            for (int ai = 0; ai < 2; ++ai)
#pragma unroll
                for (int m = 0; m < 4; ++m) { const size_t ro = (size_t)(row0 + ai * 128 + m * 16) * (MH * MDK); const float sc = C2M / sqrtf(rsv[ai * 4 + m]);
                    *(u32x4*)(q0 + ro) = pack8(acc[ai][0][m][0], acc[ai][0][m][1], sc); *(u32x4*)(q1 + ro) = pack8(acc[ai][1][m][0], acc[ai][1][m][1], sc); }
        } else {
#pragma unroll
            for (int ai = 0; ai < 2; ++ai)
#pragma unroll
                for (int m = 0; m < 4; ++m) {
                    asm volatile("" ::: "memory");
                    const int row = row0 + ai * 128 + m * 16; const float rs = 1.0f / sqrtf(rsv[ai * 4 + m]);
                    bf16_t* qm = WSA(bf16_t, WS_Z + Z_QM) + (size_t)row * (MH * MDK);
                    float2 cs8[8]; const float2* cp = WSA(float2, WS_ROPE) + (size_t)row * 16 + 8 * (fq & 1);
#pragma unroll
                    for (int j = 0; j < 8; ++j) cs8[j] = cp[j];
#pragma unroll
                    for (int bj = 0; bj < 2; ++bj) { f32x4 v0 = acc[ai][bj][m][0] * rs, v1 = acc[ai][bj][m][1] * rs;
                        rotary8(v0, v1, cs8, fq);
                        *(u32x4*)(qm + (4 * bj + wc) * MDK + NOPE + 8 * fq) = pack8(v0, v1, C2M); }
                }
        }
    }
};
struct EpiUpKV {
    static constexpr bool PERM = true; static constexpr bool F8 = false; static constexpr bool I8 = false;
    unsigned char* ws;
    __device__ __forceinline__ void operator()(const Acc& acc, const pg8::Unit& u, int wr, int wc, int fr, int fq) const {
        const int row0 = u.pm * 256 + wr * 64 + fr, pn = u.pn;
        float rsv[8];
#pragma unroll
        for (int i = 0; i < 8; ++i) rsv[i] = 0.f;
        { f32x4 sp[8]; ld8_rows_f32x4(sp, WSA(float, WS_SMALL + SM_SSQKV) + (size_t)row0 * 4);
#pragma unroll
          for (int i = 0; i < 8; ++i) rsv[i] = ((sp[i][0] + sp[i][1]) + (sp[i][2] + sp[i][3])) * (1.0f / KVL) + EPS; }
#pragma unroll
        for (int ai = 0; ai < 2; ++ai)
#pragma unroll
            for (int m = 0; m < 4; ++m) {
                asm volatile("" ::: "memory");
                const int row = row0 + ai * 128 + m * 16;
                const float rs = 1.0f / sqrtf(rsv[ai * 4 + m]);
#pragma unroll
                for (int bj = 0; bj < 2; ++bj) { const int c = (pn & 1) * 256 + bj * 128 + wc * 32 + 8 * fq;
                    bf16_t* dst = (pn < 2 ? WSA(bf16_t, WS_Z + Z_KM) : WSA(bf16_t, WS_Z + Z_VM)) + (size_t)row * MW + c;
                    *(u32x4*)dst = pack8(acc[ai][bj][m][0], acc[ai][bj][m][1], rs); }
            }
    }
};
struct EpiWo {
    static constexpr bool PERM = true; static constexpr bool F8 = false; static constexpr bool I8 = true;
    unsigned char* ws; const float* xsrc; const float* wcs;
    __device__ __forceinline__ void operator()(Acc& acc, const pg8::Unit& u, int wr, int wc, int fr, int fq) const {
        const int row0 = u.pm * 256 + wr * 64 + fr;
        { const float* cp = wcs + u.pn * 256 + wc * 32 + 8 * fq;
          const f32x4 c00 = *(const f32x4*)(cp) * (AO_C / 127.0f), c01 = *(const f32x4*)(cp + 4) * (AO_C / 127.0f), c10 = *(const f32x4*)(cp + 128) * (AO_C / 127.0f), c11 = *(const f32x4*)(cp + 132) * (AO_C / 127.0f);
#pragma unroll
          for (int ai = 0; ai < 2; ++ai)
#pragma unroll
              for (int m = 0; m < 4; ++m) {
                  acc[ai][0][m][0] = __builtin_convertvector(__builtin_bit_cast(i32x4, acc[ai][0][m][0]), f32x4) * c00; acc[ai][0][m][1] = __builtin_convertvector(__builtin_bit_cast(i32x4, acc[ai][0][m][1]), f32x4) * c01;
                  acc[ai][1][m][0] = __builtin_convertvector(__builtin_bit_cast(i32x4, acc[ai][1][m][0]), f32x4) * c10; acc[ai][1][m][1] = __builtin_convertvector(__builtin_bit_cast(i32x4, acc[ai][1][m][1]), f32x4) * c11; } }
#pragma unroll
        for (int ai = 0; ai < 2; ++ai)
#pragma unroll
            for (int m = 0; m < 4; ++m) {
                asm volatile("" ::: "memory");
                const int row = row0 + ai * 128 + m * 16;
#pragma unroll
                for (int bj = 0; bj < 2; ++bj) { const size_t off = (size_t)row * DM + u.pn * 256 + bj * 128 + wc * 32 + 8 * fq;
                    f32x4 h0, h1;
                    if (xsrc) { h0 = *(const f32x4*)(xsrc + off); h1 = *(const f32x4*)(xsrc + off + 4); }
                    else { const u32x4 hv = *(const u32x4*)(WSA(bf16_t, WS_HB) + off);
                        h0 = (f32x4){bf2f(hv.x & 0xffffu), bf2f(hv.x >> 16), bf2f(hv.y & 0xffffu), bf2f(hv.y >> 16)}; h1 = (f32x4){bf2f(hv.z & 0xffffu), bf2f(hv.z >> 16), bf2f(hv.w & 0xffffu), bf2f(hv.w >> 16)}; }
                    h0 += acc[ai][bj][m][0]; h1 += acc[ai][bj][m][1];
                    *(u32x4*)(WSA(bf16_t, WS_HB) + off) = pack8(h0, h1, 1.f);
                    { int w0 = __builtin_amdgcn_cvt_pk_fp8_f32(h0[0], h0[1], 0, false); w0 = __builtin_amdgcn_cvt_pk_fp8_f32(h0[2], h0[3], w0, true);
                      int w1 = __builtin_amdgcn_cvt_pk_fp8_f32(h1[0], h1[1], 0, false); w1 = __builtin_amdgcn_cvt_pk_fp8_f32(h1[2], h1[3], w1, true);
                      *(u32x2*)(ws + WS_X + X_H8 + off) = (u32x2){(unsigned)w0, (unsigned)w1}; } }
            }
    }
};

__device__ __forceinline__ void moe_build_tb(LAS unsigned char* lds, const unsigned* cnt, int wave, int lane) {
    if (wave == 0) {
        const int c = lane < NE ? (int)__hip_atomic_load(cnt + (lane & 31) * 64, __ATOMIC_RELAXED, __HIP_MEMORY_SCOPE_AGENT) : 0;
        const int nt = (c + 255) >> 8; int pre = nt;
#pragma unroll
        for (int o = 1; o < 64; o <<= 1) { const int v = __builtin_amdgcn_ds_bpermute((lane - o) << 2, pre); if (lane >= o) pre += v; }
        LAS int* tb = (LAS int*)(lds + TB_OFF);
        if (lane < NE) { tb[lane + 1] = pre; tb[40 + lane] = c; }
        if (lane == 0) tb[0] = 0;
    }
    asm volatile("s_waitcnt lgkmcnt(0)" ::: "memory"); __syncthreads();
}
template <int NPN, bool GATHER_>
struct MoeOrder {
    static constexpr bool GATHER = GATHER_;
    LAS const int* tb; const char* A; const char* Bt; const unsigned* list; int K, G, c; size_t bstride;
    __device__ __forceinline__ bool next(int i, pg8::Unit& u) const {
        const int L = i * G + c, total = tb[NE] * NPN; if (L >= total) return false;
        const int g = L / NPN, pn = L % NPN; int e = 0;
        for (int j = 1; j < NE; ++j) e = (tb[j] <= g) ? j : e;
        u.pm = g; u.pn = pn; u.e = e; u.tile = g - tb[e];
        u.A = GATHER_ ? A : A + (size_t)g * 256 * K * 2;
        u.B = Bt + (size_t)e * bstride + (size_t)pn * 256 * K * 2;
        return true;
    }
    __device__ __forceinline__ void lane_offs(const pg8::Unit& u, const pg8::LaneRC& rc, unsigned (&v0)[2], unsigned (&v1)[2]) const {
        if constexpr (GATHER_) {
            const int cn = tb[40 + u.e]; const unsigned* le = list + (size_t)u.e * T;
#pragma unroll
            for (int i = 0; i < 2; ++i) {
                const int p0 = u.tile * 256 + rc.R[i], p1 = p0 + 128;
                const unsigned t0 = le[p0 < cn ? p0 : 0] >> 1, t1 = le[p1 < cn ? p1 : 0] >> 1;
                v0[i] = (t0 * (unsigned)K + (unsigned)rc.C[i]) * 2u; v1[i] = (t1 * (unsigned)K + (unsigned)rc.C[i]) * 2u;
            }
        }
    }
};
struct EpiGU {
    static constexpr bool PERM = true; static constexpr bool F8 = true; static constexpr bool I8 = false;
    unsigned char* ws; LAS const int* tb;
    __device__ __forceinline__ void operator()(const Acc& acc, const pg8::Unit& u, int wr, int wc, int fr, int fq) const {
        const int cn = tb[40 + u.e]; const unsigned* le = WSA(unsigned, WS_SMALL + SM_LIST) + (size_t)u.e * T;
        unsigned tokv[8]; float rsv[8];
#pragma unroll
        for (int i = 0; i < 8; ++i) { const int pos = u.tile * 256 + (i >> 2) * 128 + wr * 64 + (i & 3) * 16 + fr; tokv[i] = le[pos < cn ? pos : 0] >> 1; }
#pragma unroll
        for (int i = 0; i < 8; ++i) rsv[i] = WSA(float, WS_SMALL + SM_RSTD2)[tokv[i]];
        unsigned char* he = ws + WS_Z + Z_HE + ((size_t)u.pm * 256 + wr * 64 + fr) * DE + u.pn * 128 + wc * 32 + 8 * fq;
#pragma unroll
        for (int ai = 0; ai < 2; ++ai)
#pragma unroll
            for (int m = 0; m < 4; ++m) { const float rs = rsv[ai * 4 + m] * (1.0f / F8_WGU);
                f32x4 h0, h1;
#pragma unroll
                for (int j = 0; j < 4; ++j) {
                    const float g0 = acc[ai][0][m][0][j] * rs, u0 = acc[ai][1][m][0][j] * rs, g1 = acc[ai][0][m][1][j] * rs, u1 = acc[ai][1][m][1][j] * rs;
                    h0[j] = g0 * __builtin_amdgcn_rcpf(1.0f + __expf(-g0)) * u0; h1[j] = g1 * __builtin_amdgcn_rcpf(1.0f + __expf(-g1)) * u1;
                }
                int w0 = __builtin_amdgcn_cvt_pk_fp8_f32(h0[0], h0[1], 0, false); w0 = __builtin_amdgcn_cvt_pk_fp8_f32(h0[2], h0[3], w0, true);
                int w1 = __builtin_amdgcn_cvt_pk_fp8_f32(h1[0], h1[1], 0, false); w1 = __builtin_amdgcn_cvt_pk_fp8_f32(h1[2], h1[3], w1, true);
                *(u32x2*)(he + (size_t)(ai * 128 + m * 16) * DE) = (u32x2){(unsigned)w0, (unsigned)w1}; }
    }
};
struct EpiDown {
    static constexpr bool PERM = true; static constexpr bool F8 = true; static constexpr bool I8 = false;
    unsigned char* ws; LAS const int* tb;
    __device__ __forceinline__ void operator()(const Acc& acc, const pg8::Unit& u, int wr, int wc, int fr, int fq) const {
        unsigned char* y = ws + WS_X + X_YT + ((size_t)u.pm * 256 + wr * 64 + fr) * DM + u.pn * 256 + wc * 32 + 8 * fq;
#pragma unroll
        for (int ai = 0; ai < 2; ++ai)
#pragma unroll
            for (int m = 0; m < 4; ++m)
#pragma unroll
                for (int bj = 0; bj < 2; ++bj) { const f32x4 v0 = acc[ai][bj][m][0] * (1.0f / F8_WD), v1 = acc[ai][bj][m][1] * (1.0f / F8_WD);
                    int w0 = __builtin_amdgcn_cvt_pk_fp8_f32(v0[0], v0[1], 0, false); w0 = __builtin_amdgcn_cvt_pk_fp8_f32(v0[2], v0[3], w0, true);
                    int w1 = __builtin_amdgcn_cvt_pk_fp8_f32(v1[0], v1[1], 0, false); w1 = __builtin_amdgcn_cvt_pk_fp8_f32(v1[2], v1[3], w1, true);
                    *(u32x2*)(y + (size_t)(ai * 128 + m * 16) * DM + bj * 128) = (u32x2){(unsigned)w0, (unsigned)w1}; }
    }
};
constexpr int WR3_BYTES = 32 * 9 * 64 * 16;
__device__ __forceinline__ void route_tile(LAS unsigned char* lds, unsigned char* ws, const float* H, unsigned* cnt, int layer, int row0, int wave, int lane, bool dry) {
    LAS unsigned* lcnt = (LAS unsigned*)(lds + 65536); LAS unsigned* lbase = lcnt + 32;
    if (wave == 0 && lane < 32) lcnt[lane] = 0u;
    asm volatile("s_waitcnt lgkmcnt(0)" ::: "memory"); __syncthreads();
    int e1 = 0, e2 = 0; unsigned p1 = 0u, p2 = 0u; float g1 = 0.f, g2 = 0.f;
    const bool act = row0 >= 0;
    const int r = lane & 15, g = lane >> 4;
    float rs = 0.f;
    LAS float* L = (LAS float*)(lds + (wave & 3) * 8192);
    if (act) {
        const u32x4* ap0 = (const u32x4*)(WSA(bf16_t, WS_HB) + (size_t)(row0 + r) * DM) + g; const u32x4* ap1 = ap0 + 16 * (DM / 8);
        const u32x4* bp = (const u32x4*)(ws + WS_WR + (size_t)layer * WR3_BYTES) + lane;
        f32x4 acc[2][3]; float ss0 = 0.f, ss1 = 0.f;
#pragma unroll
        for (int h = 0; h < 2; ++h)
#pragma unroll
            for (int cb = 0; cb < 3; ++cb) acc[h][cb] = (f32x4){0.f, 0.f, 0.f, 0.f};
        u32x4 a0n = ap0[0], a1n = ap1[0], bn[9];
#pragma unroll
        for (int f = 0; f < 9; ++f) bn[f] = bp[f * 64];
#pragma unroll 1
        for (int j = 0; j < 32; ++j) {
            const u32x4 a0 = a0n, a1 = a1n; u32x4 b[9];
#pragma unroll
            for (int f = 0; f < 9; ++f) b[f] = bn[f];
            if (j + 1 < 32) { a0n = ap0[4 * (j + 1)]; a1n = ap1[4 * (j + 1)];
#pragma unroll
                for (int f = 0; f < 9; ++f) bn[f] = bp[((j + 1) * 9 + f) * 64]; }
#pragma unroll
            for (int q = 0; q < 4; ++q) { const float x0 = bf2f(a0[q] & 0xffffu), x1 = bf2f(a0[q] >> 16), y0 = bf2f(a1[q] & 0xffffu), y1 = bf2f(a1[q] >> 16); ss0 += x0 * x0 + x1 * x1; ss1 += y0 * y0 + y1 * y1; }
#pragma unroll
            for (int t = 0; t < 3; ++t)
#pragma unroll
                for (int cb = 0; cb < 3; ++cb) {
                    acc[0][cb] = __builtin_amdgcn_mfma_f32_16x16x32_bf16(__builtin_bit_cast(bf16x8, a0), __builtin_bit_cast(bf16x8, b[t * 3 + cb]), acc[0][cb], 0, 0, 0);
                    acc[1][cb] = __builtin_amdgcn_mfma_f32_16x16x32_bf16(__builtin_bit_cast(bf16x8, a1), __builtin_bit_cast(bf16x8, b[t * 3 + cb]), acc[1][cb], 0, 0, 0); }
        }
        ss0 = xadd16(ss0); ss0 = xadd32(ss0); ss1 = xadd16(ss1); ss1 = xadd32(ss1);
        rs = 1.0f / sqrtf((g == 0 ? ss0 : ss1) * (1.0f / DM) + EPS);
#pragma unroll
        for (int h = 0; h < 2; ++h)
#pragma unroll
            for (int cb = 0; cb < 3; ++cb)
#pragma unroll
                for (int q = 0; q < 4; ++q) L[(16 * h + 4 * g + q) * 48 + cb * 16 + r] = acc[h][cb][q];
    }
    asm volatile("s_waitcnt lgkmcnt(0)" ::: "memory");
    if (act && lane < 32) {
        const int row = row0 + lane;
        float lg[40];
#pragma unroll
        for (int q = 0; q < 10; ++q) { const f32x4 v = *(LAS const f32x4*)(L + lane * 48 + 4 * q); lg[4 * q] = v[0] * rs; lg[4 * q + 1] = v[1] * rs; lg[4 * q + 2] = v[2] * rs; lg[4 * q + 3] = v[3] * rs; }
        (dry ? WSA(float, WS_AO + 8 * MiB) : WSA(float, WS_SMALL + SM_RSTD2))[row] = rs;
        int gid = 0; float gm = lg[0];
#pragma unroll
        for (int c = 1; c < 8; ++c) if (lg[c] > gm) { gm = lg[c]; gid = c; }
        float den = 0.f;
#pragma unroll
        for (int c = 0; c < 8; ++c) den += expf(lg[c] - gm);
        const float gw = 1.0f / den;
        float e4[4];
#pragma unroll
        for (int c = 0; c < 4; ++c) { float v = lg[8 + c];
#pragma unroll
            for (int gg = 1; gg < 8; ++gg) v = (gid == gg) ? lg[8 + gg * 4 + c] : v;
            e4[c] = v; }
        int i1 = 0; float v1 = e4[0];
#pragma unroll
        for (int c = 1; c < 4; ++c) if (e4[c] > v1) { v1 = e4[c]; i1 = c; }
        int i2 = -1; float v2 = -INFINITY;
#pragma unroll
        for (int c = 0; c < 4; ++c) if (c != i1 && e4[c] > v2) { v2 = e4[c]; i2 = c; }
        const float ex = expf(v2 - v1); g1 = gw / (1.0f + ex); g2 = gw * ex / (1.0f + ex);
        e1 = gid * 4 + i1; e2 = gid * 4 + i2;
        p1 = __hip_atomic_fetch_add(lcnt + e1, 1u, __ATOMIC_RELAXED, __HIP_MEMORY_SCOPE_WORKGROUP); p2 = __hip_atomic_fetch_add(lcnt + e2, 1u, __ATOMIC_RELAXED, __HIP_MEMORY_SCOPE_WORKGROUP);
    }
    asm volatile("s_waitcnt lgkmcnt(0)" ::: "memory"); __syncthreads();
    if (wave == 0 && lane < 32) lbase[lane] = atomicAdd(cnt + lane * 64, lcnt[lane]);
    asm volatile("s_waitcnt vmcnt(0) lgkmcnt(0)" ::: "memory"); __syncthreads();
    if (act && lane < 32) {
        const int row = row0 + lane;
        unsigned* list = dry ? WSA(unsigned, WS_AO) : WSA(unsigned, WS_SMALL + SM_LIST);
        const unsigned q1 = lbase[e1] + p1, q2 = lbase[e2] + p2;
        list[(size_t)e1 * T + q1] = (unsigned)row * 2u; list[(size_t)e2 * T + q2] = (unsigned)row * 2u + 1u;
        if (!dry) { unsigned* tsl = WSA(unsigned, WS_SMALL + SM_TSLOT) + (size_t)row * 2; tsl[0] = (q1 << 5) | (unsigned)e1; tsl[1] = (q2 << 5) | (unsigned)e2; }
        float* gt = dry ? WSA(float, WS_AO + 9 * MiB) : WSA(float, WS_SMALL + SM_GATE); gt[row * 2] = g1; gt[row * 2 + 1] = g2;
    }
    asm volatile("s_waitcnt lgkmcnt(0)" ::: "memory");
}
__device__ __forceinline__ void combine_row(unsigned char* ws, float* out, const float* final_norm, int last, int row, int lane, bool dry, LAS const int* tb) {
    const unsigned long long* hb = (const unsigned long long*)(WSA(bf16_t, WS_HB) + (size_t)row * DM) + lane;
    const unsigned t0 = WSA(unsigned, WS_SMALL + SM_TSLOT)[(size_t)row * 2], t1 = WSA(unsigned, WS_SMALL + SM_TSLOT)[(size_t)row * 2 + 1];
    const float g0 = WSA(float, WS_SMALL + SM_GATE)[row * 2], g1 = WSA(float, WS_SMALL + SM_GATE)[row * 2 + 1];
    const size_t a0 = (size_t)tb[t0 & 31u] * 256 + (t0 >> 5), a1 = (size_t)tb[t1 & 31u] * 256 + (t1 >> 5);
    const unsigned* y0 = (const unsigned*)(ws + WS_X + X_YT + a0 * DM) + lane; const unsigned* y1 = (const unsigned*)(ws + WS_X + X_YT + a1 * DM) + lane;
    f32x4 v[4]; float s = 0.f;
#pragma unroll
    for (int j = 0; j < 4; ++j) { const unsigned long long c = hb[64 * j]; const int a = (int)y0[64 * j], b = (int)y1[64 * j];
        v[j].x = bf2f((unsigned)c & 0xffffu) + (g0 * __builtin_amdgcn_cvt_f32_fp8(a, 0) + g1 * __builtin_amdgcn_cvt_f32_fp8(b, 0));
        v[j].y = bf2f(((unsigned)c) >> 16) + (g0 * __builtin_amdgcn_cvt_f32_fp8(a, 1) + g1 * __builtin_amdgcn_cvt_f32_fp8(b, 1));
        v[j].z = bf2f((unsigned)(c >> 32) & 0xffffu) + (g0 * __builtin_amdgcn_cvt_f32_fp8(a, 2) + g1 * __builtin_amdgcn_cvt_f32_fp8(b, 2));
        v[j].w = bf2f((unsigned)(c >> 48)) + (g0 * __builtin_amdgcn_cvt_f32_fp8(a, 3) + g1 * __builtin_amdgcn_cvt_f32_fp8(b, 3));
        s += v[j].x * v[j].x + v[j].y * v[j].y + v[j].z * v[j].z + v[j].w * v[j].w; }
    s = wave_sum(s);
    const float rs = 1.0f / sqrtf(s * (1.0f / DM) + EPS);
    if (last) {
        const f32x4* g = (const f32x4*)final_norm + lane; f32x4* ho = (f32x4*)((dry ? WSA(float, WS_Z + 64 * MiB) : out) + (size_t)row * DM) + lane;
#pragma unroll
        for (int j = 0; j < 4; ++j) { const f32x4 gg = g[64 * j]; ho[64 * j] = (f32x4){v[j].x * rs * gg.x, v[j].y * rs * gg.y, v[j].z * rs * gg.z, v[j].w * rs * gg.w}; }
    } else {
        unsigned long long* o8 = (unsigned long long*)((dry ? WSA(bf16_t, WS_AO) : WSA(bf16_t, WS_HB)) + (size_t)row * DM) + lane;
#pragma unroll
        for (int j = 0; j < 4; ++j) o8[64 * j] = (unsigned long long)pk2(v[j].x, v[j].y) | ((unsigned long long)pk2(v[j].z, v[j].w) << 32);
        float mx = 0.f;
#pragma unroll
        for (int j = 0; j < 4; ++j) mx = fmaxf(fmaxf(mx, fmaxf(fabsf(v[j].x), fabsf(v[j].y))), fmaxf(fabsf(v[j].z), fabsf(v[j].w)));
        mx = wave_max0(mx); const float inv = mx > 0.f ? 127.0f / mx : 0.f;
        if (!dry) { unsigned* a8 = (unsigned*)(ws + WS_Z + Z_A8 + (size_t)row * DM) + lane;
#pragma unroll
            for (int j = 0; j < 4; ++j) a8[64 * j] = q4_i8(v[j].x, v[j].y, v[j].z, v[j].w, inv); }
        if (lane == 0 && !dry) WSA(float, WS_SMALL + SM_RSTD)[row] = rs * (mx * (1.0f / 127.0f));
    }
}

constexpr int AT_NSLOT = 3, AT_KBUF = 0, AT_KSTRIDE = 12288, AT_VBUF = AT_NSLOT * 12288, AT_VSTRIDE = 8192, AT_WSF = AT_VBUF + AT_NSLOT * 8192, AT_OST = AT_WSF + 2048;
static_assert(AT_OST + 65536 <= RING_BYTES, "attention LDS map");
constexpr float AT_THR = 8.0f;
__device__ __forceinline__ int crow(int r, int hi) { return (r & 3) + 8 * (r >> 2) + 4 * hi; }
typedef short s16x4 __attribute__((ext_vector_type(4)));
__device__ __forceinline__ s16x4 vtr(LAS const unsigned char* p) { return __builtin_bit_cast(s16x4, __builtin_amdgcn_ds_read_tr16_b64_v4i16((LAS s16x4*)p)); }
__device__ __forceinline__ unsigned cvtpk(float lo, float hi) { typedef float f2 __attribute__((ext_vector_type(2))); typedef __bf16 b2 __attribute__((ext_vector_type(2))); f2 v = {lo, hi}; b2 b = __builtin_convertvector(v, b2); return __builtin_bit_cast(unsigned, b); }
__device__ __forceinline__ unsigned cvtpk_v(float lo, float hi) { unsigned r; asm volatile("v_cvt_pk_bf16_f32 %0, %1, %2" : "=v"(r) : "v"(lo), "v"(hi)); return r; }
__device__ __forceinline__ float xmax32(float v) { const unsigned a = __builtin_bit_cast(unsigned, v); auto r = __builtin_amdgcn_permlane32_swap(a, a, false, false); const unsigned x = r[0], y = r[1]; return fmaxf(__builtin_bit_cast(float, x), __builtin_bit_cast(float, y)); }

__device__ __forceinline__ void glds16(const void* gsrc, unsigned lds_dst) { unsigned keep;
    asm volatile("s_mov_b32 %0, m0\n\ts_mov_b32 m0, %2\n\ts_nop 0\n\tglobal_load_lds_dwordx4 %1, off\n\ts_mov_b32 m0, %0" : "=&s"(keep) : "v"(gsrc), "s"(lds_dst) : "memory"); }
__device__ __forceinline__ int attn_prefetch(LAS unsigned char* lds, unsigned char* ws, const unsigned un, const int vslot, const int wave, const int lane, bf16x8 (&qn)[6]) {
    const bool nfox = (un & 1u) != 0u; const int qb = 15 - (int)(un >> 7), bh = (int)(un & 127u) >> 1, b = bh >> 3, h = bh & 7;
    const size_t row0 = (size_t)b * SEQ;
    int t0 = 0;
    if (nfox && qb > 0) {
        const float* km2 = WSA(float, WS_SMALL + SM_D + 20480) + (size_t)b * 16 * 8 + h; float kk = 0.f;
        for (int j = 0; j < 16; ++j) kk = fmaxf(kk, km2[j * 8]);
        const float qq = WSA(float, WS_SMALL + SM_D + 16384)[((size_t)b * 16 + qb) * 8 + h];
        const float bound = 2.05f * sqrtf(qq * kk) + 48.0f;
        const float* dt = WSA(float, WS_SMALL + SM_D + 32768) + ((size_t)b * 8 + h) * 64; const float dref = dt[4 * qb - 1];
        const bool far = (lane < 4 * qb) && (dref - dt[lane] <= -bound);
        t0 = __popcll(__ballot(far));
    }
    const bf16_t* Km_ = (nfox ? WSA(bf16_t, WS_X + X_FK) : WSA(bf16_t, WS_Z + Z_KM)) + h * 64;
    const bf16_t* Vm_ = (nfox ? WSA(bf16_t, WS_X + X_FV) : WSA(bf16_t, WS_Z + Z_VM)) + h * 64;
    const int krow = wave * 8 + (lane >> 3), kch = (lane & 7) ^ ((krow >> 1) & 7);
    const bf16_t* ksrc0 = Km_ + (row0 + krow) * 512 + kch * 8 + (size_t)t0 * 64 * 512;
    const int xrow = wave * 16 + (lane >> 2);
    const bf16_t* ksrc1 = nfox ? WSA(bf16_t, WS_X + X_KA) + (((size_t)b * 8 + h) * SEQ + lane) * 8 + (size_t)t0 * 64 * 8
                               : WSA(bf16_t, WS_Z + Z_KR) + (row0 + xrow) * ROPE + ((lane & 3) ^ ((xrow >> 2) & 3)) * 8 + (size_t)t0 * 64 * ROPE;
    const size_t katile = nfox ? (size_t)64 * 8 : (size_t)64 * ROPE;
    const bool k1 = nfox ? (wave == 0) : (wave < 4);
    const bf16_t* vsrc = Vm_ + (row0 + 16 * (wave & 3) + (lane >> 2)) * 512 + (wave >> 2) * 32 + (lane & 3) * 8 + (size_t)t0 * 64 * 512;
    const unsigned lds0 = (unsigned)(unsigned long)lds;
    glds16(ksrc0, (unsigned)__builtin_amdgcn_readfirstlane(lds0 + AT_KBUF + wave * 1024));
    if (k1) glds16(ksrc1, (unsigned)__builtin_amdgcn_readfirstlane(lds0 + AT_KBUF + 8192 + wave * 1024));
    glds16(ksrc0 + (size_t)64 * 512, (unsigned)__builtin_amdgcn_readfirstlane(lds0 + AT_KBUF + AT_KSTRIDE + wave * 1024));
    if (k1) glds16(ksrc1 + katile, (unsigned)__builtin_amdgcn_readfirstlane(lds0 + AT_KBUF + AT_KSTRIDE + 8192 + wave * 1024));
    glds16(vsrc, (unsigned)__builtin_amdgcn_readfirstlane(lds0 + AT_VBUF + vslot * AT_VSTRIDE + wave * 1024));
    { const int r32 = lane & 31, hi = lane >> 5; const size_t qr_ = row0 + (size_t)qb * 256 + wave * 32 + r32;
      const bf16_t* qrow = nfox ? WSA(bf16_t, WS_X + X_FQ) + h * 64 + qr_ * FW + hi * 8 : WSA(bf16_t, WS_Z + Z_QM) + h * MDK + qr_ * (MH * MDK) + hi * 8;
      const bf16_t* q4 = nfox ? WSA(bf16_t, WS_X + X_QA) + h * 8 + qr_ * 64 : qrow + 64;
      const bf16_t* q5 = nfox ? q4 : qrow + 80;
#pragma unroll
      for (int d0 = 0; d0 < 4; ++d0) qn[d0] = *(const bf16x8*)(qrow + d0 * 16);
      qn[4] = *(const bf16x8*)q4; qn[5] = *(const bf16x8*)q5; }
    return t0;
}
template <bool FOX, int ABL>
__device__ __forceinline__ void attn_unit(LAS unsigned char* lds, unsigned char* ws, const int b, const int h, const int qb, const int wave_in, int lane, const bool dry,
                                          const bool pre, const int t0p, const int vs0, const unsigned raw, volatile LAS unsigned* qword, unsigned& unext, int& t0n, int& vsn, bf16x8 (&qx)[6]) {
    asm volatile("" : "+v"(lane));
    int wave = wave_in; asm volatile("" : "+s"(wave));
    constexpr int DKS = FOX ? 5 : 6;
    const int r32 = lane & 31, hi = lane >> 5;
    const size_t row0 = (size_t)b * SEQ; const int q0 = qb * 256;
    const bf16_t* Qm_; const bf16_t* Km_; int qkp; constexpr int kp = 512;
    if (FOX) { Qm_ = WSA(bf16_t, WS_X + X_FQ) + h * 64; Km_ = WSA(bf16_t, WS_X + X_FK) + h * 64; qkp = FW; }
    else { Qm_ = WSA(bf16_t, WS_Z + Z_QM) + h * MDK; Km_ = WSA(bf16_t, WS_Z + Z_KM) + h * 64; qkp = MH * MDK; }
    const bf16_t* Vm_ = FOX ? WSA(bf16_t, WS_X + X_FV) + h * 64 : WSA(bf16_t, WS_Z + Z_VM) + h * 64;
    const bf16_t* QA = WSA(bf16_t, WS_X + X_QA) + h * 8;
    const int krow = wave * 8 + (lane >> 3), kch = (lane & 7) ^ ((krow >> 1) & 7);
    const bf16_t* ksrc0 = Km_ + (row0 + krow) * kp + kch * 8;
    const int xrow = FOX ? lane : (wave * 16 + (lane >> 2));
    const bf16_t* ksrc1 = FOX ? WSA(bf16_t, WS_X + X_KA) + (((size_t)b * 8 + h) * SEQ + lane) * 8 : WSA(bf16_t, WS_Z + Z_KR) + (row0 + xrow) * ROPE + ((lane & 3) ^ ((xrow >> 2) & 3)) * 8;
    const bool k1 = FOX ? (wave == 0) : (wave < 4);
    const bf16_t* vsrc = Vm_ + (row0 + 16 * (wave & 3) + (lane >> 2)) * 512 + (wave >> 2) * 32 + (lane & 3) * 8;
    const size_t ktile = (size_t)64 * kp, katile = FOX ? (size_t)64 * 8 : (size_t)64 * ROPE, vtile = (size_t)64 * 512;
    const unsigned lds0 = (unsigned)(unsigned long)lds;
#define AT_RFL(x) ((unsigned)__builtin_amdgcn_readfirstlane(x))
#define AT_DMAK(t, slot) do { glds16(ksrc0 + (size_t)(t) * ktile, AT_RFL(lds0 + AT_KBUF + (slot) * AT_KSTRIDE + wave * 1024)); \
        if (k1) glds16(ksrc1 + (size_t)(t) * katile, AT_RFL(lds0 + AT_KBUF + (slot) * AT_KSTRIDE + 8192 + wave * 1024)); } while (0)
#define AT_DMAV(t, slot) glds16(vsrc + (size_t)(t) * vtile, AT_RFL(lds0 + AT_VBUF + (slot) * AT_VSTRIDE + wave * 1024))
    int t0 = t0p;
    if (!pre) {
      if (FOX && qb > 0) {
        const float* km2 = WSA(float, WS_SMALL + SM_D + 20480) + (size_t)b * 16 * 8 + h; float kk = 0.f;
        for (int j = 0; j < 16; ++j) kk = fmaxf(kk, km2[j * 8]);
        const float qq = WSA(float, WS_SMALL + SM_D + 16384)[((size_t)b * 16 + qb) * 8 + h];
        const float bound = 2.05f * sqrtf(qq * kk) + 48.0f;
        const float* dt = WSA(float, WS_SMALL + SM_D + 32768) + ((size_t)b * 8 + h) * 64; const float dref = dt[4 * qb - 1];
        const bool far = (lane < 4 * qb) && (dref - dt[lane] <= -bound);
        t0 = __popcll(__ballot(far));
      }
      asm volatile("s_waitcnt lgkmcnt(0)" ::: "memory"); __builtin_amdgcn_s_barrier(); asm volatile("" ::: "memory");
    }
    if (!pre) { AT_DMAK(t0, 0); AT_DMAK(t0 + 1, 1); AT_DMAV(t0, vs0); }
    bf16x8 qr[DKS];
    if (pre) {
#pragma unroll
      for (int d0 = 0; d0 < DKS; ++d0) qr[d0] = qx[d0];
    } else { const bf16_t* qrow = Qm_ + (row0 + q0 + wave * 32 + r32) * qkp + hi * 8;
#pragma unroll
      for (int d0 = 0; d0 < (FOX ? 4 : 6); ++d0) qr[d0] = *(const bf16x8*)(qrow + d0 * 16);
      if (FOX) qr[DKS - 1] = *(const bf16x8*)(QA + (row0 + q0 + wave * 32 + r32) * 64); }
    if (FOX) { if (hi) qr[DKS - 1] = (bf16x8){0, 0, 0, 0, 0, 0, 0, 0}; }
    LAS float* wsf = (LAS float*)(lds + AT_WSF) + wave * 64;
    float mhat = 0.f, l_reg = 0.f; f32x16 o0 = {}, o1 = {}, negm = {};
    const int NT = (q0 + 256) / 64, qrel = wave * 32 + r32;
    const int ksw = (r32 >> 1) & 7, ksx = (r32 >> 2) & 3;
    const int voff = ((lane >> 4) & 1) * 32 + (lane & 3) * 8 + (4 * hi + ((lane & 15) >> 2)) * 64;
#define SBAR() __builtin_amdgcn_sched_barrier(0)
#define AT_KRD(D0, F0, F1) do { \
        if ((D0) < 4) { const int o_ = r32 * 128 + (((2 * (D0) + hi) ^ ksw) << 4); F0 = *(LAS const bf16x8*)(kb + o_); F1 = *(LAS const bf16x8*)(kb + o_ + 4096); } \
        else if (FOX) { const int o_ = 8192 + r32 * 16; F0 = *(LAS const bf16x8*)(kb + o_); F1 = *(LAS const bf16x8*)(kb + o_ + 512); } \
        else { const int o_ = 8192 + r32 * 64 + (((2 * ((D0) - 4) + hi) ^ ksx) << 4); F0 = *(LAS const bf16x8*)(kb + o_); F1 = *(LAS const bf16x8*)(kb + o_ + 2048); } } while (0)
#define AT_VRD(i) do { vlo[i] = vtr(vb + ((i) >> 2) * 4096 + ((i) & 3) * 1024); vhi[i] = vtr(vb + ((i) >> 2) * 4096 + ((i) & 3) * 1024 + 512); } while (0)
#define AT_VFR(i) (bf16x8){vlo[i][0], vlo[i][1], vlo[i][2], vlo[i][3], vhi[i][0], vhi[i][1], vhi[i][2], vhi[i][3]}
#define AT_PIN(x) asm volatile("" : "+v"(x))
#define AT_ROWMAX(C0, C1, RM) do { float a = fmaxf(fmaxf(C0[0], C0[1]), C1[0]), bb = fmaxf(fmaxf(C0[2], C0[3]), C1[1]); a = fmaxf(fmaxf(a, C1[2]), C1[3]); \
        _Pragma("unroll") for (int r = 4; r < 16; r += 4) { a = fmaxf(fmaxf(a, C0[r]), C0[r + 1]); bb = fmaxf(fmaxf(bb, C0[r + 2]), C0[r + 3]); a = fmaxf(fmaxf(a, C1[r]), C1[r + 1]); bb = fmaxf(fmaxf(bb, C1[r + 2]), C1[r + 3]); } \
        RM = xmax32(fmaxf(a, bb)); } while (0)
#define AT_MASK(C0, C1, T) do { const int jb = (T) - (NT - 4); if (jb >= 0) { const int kb0 = 64 * jb + 4 * hi; \
        _Pragma("unroll") for (int r = 0; r < 16; ++r) { const int kv = kb0 + (r & 3) + 8 * (r >> 2); if (kv > qrel) C0[r] = -INFINITY; if (kv + 32 > qrel) C1[r] = -INFINITY; } } } while (0)
#define AT_GAPA(I, P0, P1) do { \
        if ((I) < 4) { sacc += P0[4 * (I)]; sacc += P0[4 * (I) + 1]; sacc += P0[4 * (I) + 2]; sacc += P0[4 * (I) + 3]; } \
        else { sacc += P1[4 * ((I) - 4)]; sacc += P1[4 * ((I) - 4) + 1]; sacc += P1[4 * ((I) - 4) + 2]; sacc += P1[4 * ((I) - 4) + 3]; } \
        AT_PIN(sacc); \
        if ((I) == 0) { pw0[0] = cvtpk_v(P0[0], P0[1]); pw0[1] = cvtpk_v(P0[2], P0[3]); AT_PIN(pw0); } \
        if ((I) == 1) { pw0[2] = cvtpk_v(P0[4], P0[5]); pw0[3] = cvtpk_v(P0[6], P0[7]); AT_PIN(pw0); } \
        if ((I) == 2) { pw1[0] = cvtpk_v(P0[8], P0[9]); pw1[1] = cvtpk_v(P0[10], P0[11]); AT_PIN(pw1); } \
        if ((I) == 3) { pw1[2] = cvtpk_v(P0[12], P0[13]); pw1[3] = cvtpk_v(P0[14], P0[15]); AT_PIN(pw1); } \
        if ((I) == 4) { pw2[0] = cvtpk_v(P1[0], P1[1]); pw2[1] = cvtpk_v(P1[2], P1[3]); AT_PIN(pw2); } \
        if ((I) == 5) { pw2[2] = cvtpk_v(P1[4], P1[5]); pw2[3] = cvtpk_v(P1[6], P1[7]); AT_PIN(pw2); } \
        if ((I) == 6) { pw3[0] = cvtpk_v(P1[8], P1[9]); pw3[1] = cvtpk_v(P1[10], P1[11]); AT_PIN(pw3); } \
        if ((I) == 7) { pw3[2] = cvtpk_v(P1[12], P1[13]); pw3[3] = cvtpk_v(P1[14], P1[15]); AT_PIN(pw3); } } while (0)
#define AT_STEP(C0, C1, P0, P1, T, KS, VS, KS2, VS2) do { \
        LAS const unsigned char* kb = lds + AT_KBUF + (KS) * AT_KSTRIDE; LAS const unsigned char* vb = lds + AT_VBUF + (VS) * AT_VSTRIDE + voff; \
        bf16x8 kfa0, kfa1, kfb0, kfb1; s16x4 vlo[8], vhi[8]; u32x4 pw0, pw1, pw2, pw3; float sacc = 0.f; \
        SBAR(); AT_KRD(0, kfa0, kfa1); SBAR(); \
          \
        _Pragma("unroll") for (int d0 = 0; d0 < DKS; ++d0) { \
            if (d0 + 1 < DKS) { if (d0 & 1) AT_KRD(d0 + 1, kfa0, kfa1); else AT_KRD(d0 + 1, kfb0, kfb1); } \
            if (2 * d0 < 8) AT_VRD(2 * d0 < 8 ? (((2 * d0) & 1) * 4 + ((2 * d0) >> 1)) : 0); \
            SBAR(); \
            C0 = __builtin_amdgcn_mfma_f32_32x32x16_bf16((d0 & 1) ? kfb0 : kfa0, qr[d0], d0 == 0 ? negm : C0, 0, 0, 0); \
            if (2 * d0 < 8) AT_GAPA(2 * d0 < 8 ? 2 * d0 : 0, P0, P1); \
            SBAR(); \
            if (2 * d0 + 1 < 8) AT_VRD(2 * d0 + 1 < 8 ? (((2 * d0 + 1) & 1) * 4 + ((2 * d0 + 1) >> 1)) : 0); \
            SBAR(); \
            C1 = __builtin_amdgcn_mfma_f32_32x32x16_bf16((d0 & 1) ? kfb1 : kfa1, qr[d0], d0 == 0 ? negm : C1, 0, 0, 0); \
            if (2 * d0 + 1 < 8) AT_GAPA(2 * d0 + 1 < 8 ? 2 * d0 + 1 : 0, P0, P1); \
            SBAR(); } \
        l_reg += sacc; \
        if ((T) + 2 < NT) AT_DMAK((T) + 2, KS2); \
        if ((T) + 1 < NT) AT_DMAV((T) + 1, VS2); \
        AT_MASK(C0, C1, T); \
        float rm; AT_ROWMAX(C0, C1, rm); \
        bool resc = false; \
        if (__builtin_expect(__any(rm > AT_THR), 0)) { const float dl = fmaxf(rm, 0.f); mhat += dl; \
            _Pragma("unroll") for (int r = 0; r < 16; ++r) { C0[r] -= dl; C1[r] -= dl; negm[r] = -mhat; } \
            const float f = __builtin_amdgcn_exp2f(-dl); l_reg *= f; { int ro_ = r32; asm volatile("" : "+v"(ro_)); if (hi == 0) wsf[ro_] = f; } resc = true; } \
        SBAR(); \
          \
        AT_GAPB(o0, pw0, 0, C0, 0); AT_GAPB(o1, pw0, 4, C0, 4); AT_GAPB(o0, pw1, 1, C0, 8); AT_GAPB(o1, pw1, 5, C0, 12); \
        AT_GAPB(o0, pw2, 2, C1, 0); AT_GAPB(o1, pw2, 6, C1, 4); AT_GAPB(o0, pw3, 3, C1, 8); AT_GAPB(o1, pw3, 7, C1, 12); \
        if (resc) { asm volatile("s_waitcnt lgkmcnt(0)" ::: "memory"); \
            _Pragma("unroll") for (int r = 0; r < 16; ++r) { const float fr_ = wsf[crow(r, hi)]; o0[r] *= fr_; o1[r] *= fr_; } } \
    } while (0)
#define AT_GAPB(ODST, PW, VI, X, B) do { ODST = __builtin_amdgcn_mfma_f32_32x32x16_bf16(__builtin_bit_cast(bf16x8, PW), AT_VFR(VI), ODST, 0, 0, 0); \
        X[B] = __builtin_amdgcn_exp2f(X[B]); X[(B) + 1] = __builtin_amdgcn_exp2f(X[(B) + 1]); X[(B) + 2] = __builtin_amdgcn_exp2f(X[(B) + 2]); X[(B) + 3] = __builtin_amdgcn_exp2f(X[(B) + 3]); AT_PIN(X); SBAR(); } while (0)
#define AT_ENDSTEP(T) do { if ((T) + 2 < NT) { if (k1) asm volatile("s_waitcnt vmcnt(3) lgkmcnt(0)" ::: "memory"); else asm volatile("s_waitcnt vmcnt(2) lgkmcnt(0)" ::: "memory"); } \
        else asm volatile("s_waitcnt vmcnt(0) lgkmcnt(0)" ::: "memory"); \
        __builtin_amdgcn_s_barrier(); asm volatile("" ::: "memory"); } while (0)
    f32x16 pa0, pa1, pb0, pb1;
    if (pre) asm volatile("s_waitcnt vmcnt(4)" ::: "memory");
    else if (k1) asm volatile("s_waitcnt vmcnt(3)" ::: "memory"); else asm volatile("s_waitcnt vmcnt(2)" ::: "memory");
    __builtin_amdgcn_s_barrier(); asm volatile("" ::: "memory");
    AT_DMAK(t0 + 2, 2); AT_DMAV(t0 + 1, (vs0 == 2 ? 0 : vs0 + 1));
    { LAS const unsigned char* kb = lds + AT_KBUF;
#pragma unroll
      for (int d0 = 0; d0 < DKS; ++d0) { bf16x8 f0, f1; AT_KRD(d0, f0, f1);
          pa0 = __builtin_amdgcn_mfma_f32_32x32x16_bf16(f0, qr[d0], d0 == 0 ? negm : pa0, 0, 0, 0); pa1 = __builtin_amdgcn_mfma_f32_32x32x16_bf16(f1, qr[d0], d0 == 0 ? negm : pa1, 0, 0, 0); }
      AT_MASK(pa0, pa1, t0);
      float rm; AT_ROWMAX(pa0, pa1, rm); mhat = rm;
#pragma unroll
      for (int r = 0; r < 16; ++r) { pa0[r] = __builtin_amdgcn_exp2f(pa0[r] - rm); pa1[r] = __builtin_amdgcn_exp2f(pa1[r] - rm); negm[r] = -mhat; } }
    if (t0 + 2 < NT) { if (k1) asm volatile("s_waitcnt vmcnt(3) lgkmcnt(0)" ::: "memory"); else asm volatile("s_waitcnt vmcnt(2) lgkmcnt(0)" ::: "memory"); }
    else asm volatile("s_waitcnt vmcnt(0) lgkmcnt(0)" ::: "memory");
    if (wave == 0 && lane == 0) { unsigned rw = raw; asm volatile("" : "+v"(rw)); qword[0] = rw; }
    __builtin_amdgcn_s_barrier(); asm volatile("" ::: "memory");
    int t = t0 + 1;
    int ks = 1, vs = vs0;
#define AT_NEXT3(x) ((x) == 2 ? 0 : (x) + 1)
#define AT_PREV3(x) ((x) == 0 ? 2 : (x) - 1)
    if ((NT - t) & 1) {
        AT_STEP(pb0, pb1, pa0, pa1, t, ks, vs, AT_PREV3(ks), AT_NEXT3(AT_NEXT3(vs))); AT_ENDSTEP(t);
        pa0 = pb0; pa1 = pb1; ++t; ks = AT_NEXT3(ks); vs = AT_NEXT3(vs);
    }
#pragma unroll 1
    for (; t < NT; t += 2) {
        AT_STEP(pb0, pb1, pa0, pa1, t, ks, vs, AT_PREV3(ks), AT_NEXT3(AT_NEXT3(vs))); AT_ENDSTEP(t);
        ks = AT_NEXT3(ks); vs = AT_NEXT3(vs);
        AT_STEP(pa0, pa1, pb0, pb1, t + 1, ks, vs, AT_PREV3(ks), AT_NEXT3(AT_NEXT3(vs))); AT_ENDSTEP(t + 1);
        ks = AT_NEXT3(ks); vs = AT_NEXT3(vs);
    }
    unext = qword[0]; vsn = (vs == 2 ? 0 : vs + 1); t0n = 0;
    if (unext < 2048u) t0n = attn_prefetch(lds, ws, unext, vsn, wave, lane, qx);
    else {
#pragma unroll
        for (int d0 = 0; d0 < 6; ++d0) qx[d0] = qr[d0 < DKS ? d0 : 0]; }
    { float sacc = 0.f;
#pragma unroll
      for (int r = 0; r < 16; ++r) sacc += pa0[r] + pa1[r];
      l_reg += sacc;
      const u32x4 pw0 = {cvtpk(pa0[0], pa0[1]), cvtpk(pa0[2], pa0[3]), cvtpk(pa0[4], pa0[5]), cvtpk(pa0[6], pa0[7])}, pw1 = {cvtpk(pa0[8], pa0[9]), cvtpk(pa0[10], pa0[11]), cvtpk(pa0[12], pa0[13]), cvtpk(pa0[14], pa0[15])};
      const u32x4 pw2 = {cvtpk(pa1[0], pa1[1]), cvtpk(pa1[2], pa1[3]), cvtpk(pa1[4], pa1[5]), cvtpk(pa1[6], pa1[7])}, pw3 = {cvtpk(pa1[8], pa1[9]), cvtpk(pa1[10], pa1[11]), cvtpk(pa1[12], pa1[13]), cvtpk(pa1[14], pa1[15])};
      LAS const unsigned char* vb = lds + AT_VBUF + vs * AT_VSTRIDE + voff; s16x4 vlo[8], vhi[8];
#pragma unroll
      for (int i = 0; i < 8; ++i) AT_VRD(i);
      o0 = __builtin_amdgcn_mfma_f32_32x32x16_bf16(__builtin_bit_cast(bf16x8, pw0), AT_VFR(0), o0, 0, 0, 0); o1 = __builtin_amdgcn_mfma_f32_32x32x16_bf16(__builtin_bit_cast(bf16x8, pw0), AT_VFR(4), o1, 0, 0, 0);
      o0 = __builtin_amdgcn_mfma_f32_32x32x16_bf16(__builtin_bit_cast(bf16x8, pw1), AT_VFR(1), o0, 0, 0, 0); o1 = __builtin_amdgcn_mfma_f32_32x32x16_bf16(__builtin_bit_cast(bf16x8, pw1), AT_VFR(5), o1, 0, 0, 0);
      o0 = __builtin_amdgcn_mfma_f32_32x32x16_bf16(__builtin_bit_cast(bf16x8, pw2), AT_VFR(2), o0, 0, 0, 0); o1 = __builtin_amdgcn_mfma_f32_32x32x16_bf16(__builtin_bit_cast(bf16x8, pw2), AT_VFR(6), o1, 0, 0, 0);
      o0 = __builtin_amdgcn_mfma_f32_32x32x16_bf16(__builtin_bit_cast(bf16x8, pw3), AT_VFR(3), o0, 0, 0, 0); o1 = __builtin_amdgcn_mfma_f32_32x32x16_bf16(__builtin_bit_cast(bf16x8, pw3), AT_VFR(7), o1, 0, 0, 0); }
#undef AT_STEP
#undef AT_GAPA
#undef AT_GAPB
#undef AT_ENDSTEP
#undef AT_KRD
#undef AT_VRD
#undef AT_VFR
#undef AT_PIN
#undef AT_ROWMAX
#undef AT_MASK
#undef AT_NEXT3
#undef AT_PREV3
#undef SBAR
#undef AT_DMAK
#undef AT_DMAV
#undef AT_RFL
    l_reg = xadd32(l_reg);
    if (hi == 0) wsf[32 + r32] = l_reg;
    asm volatile("s_waitcnt lgkmcnt(0)" ::: "memory");
    LAS float* stg = (LAS float*)(lds + AT_OST) + wave * 2048;
#pragma unroll
    for (int r = 0; r < 16; ++r) { const int orow = crow(r, hi); const float il = __builtin_amdgcn_rcpf(wsf[32 + orow]);
        stg[orow * 64 + r32] = o0[r] * il; stg[orow * 64 + 32 + r32] = o1[r] * il; }
    asm volatile("s_waitcnt lgkmcnt(0)" ::: "memory");
    unsigned char* ao = ws + (dry ? WS_HB : WS_AO) + (row0 + q0 + wave * 32) * DM + (FOX ? 0 : FW) + h * 64;
#pragma unroll
    for (int i = 0; i < 4; ++i) { const int row = i * 8 + (lane >> 3), ch = lane & 7;
        const f32x4 a = *(LAS const f32x4*)(stg + row * 64 + ch * 8), bq = *(LAS const f32x4*)(stg + row * 64 + ch * 8 + 4);
        float ss = sq8(a, bq); ss += dppf<0xB1>(ss); ss += dppf<0x4E>(ss); ss += dppf<0x141>(ss);
        const float rs = 1.0f / sqrtf(ss * (1.0f / 64.0f) + EPS);
        const float qs = rs * (127.0f / AO_C);
        *(u32x2*)(ao + (size_t)row * DM + ch * 8) = (u32x2){q4_i8c(a[0], a[1], a[2], a[3], qs), q4_i8c(bq[0], bq[1], bq[2], bq[3], qs)}; }
    asm volatile("" : "+v"(qx[0]), "+v"(qx[1]), "+v"(qx[2]), "+v"(qx[3]), "+v"(qx[4]), "+v"(qx[5]));
}
constexpr int CW_ATTQ = 15360;
template <int ABL>
__device__ __forceinline__ void attn_phase(LAS unsigned char* lds, unsigned char* ws, unsigned* qhead, int wave, int lane, bool dry) {
    volatile LAS unsigned* qw = (volatile LAS unsigned*)(lds + MISC_OFF + 64);
    const bool leader = (wave == 0 && lane == 0);
    if (leader) qw[0] = atomicAdd(qhead, 1u);
    asm volatile("s_waitcnt vmcnt(0) lgkmcnt(0)" ::: "memory"); __syncthreads();
    unsigned u = qw[0];
    bool pre = false; int t0p = 0, vs0 = 0, par = 0; bf16x8 qx[6];
#pragma unroll 1
    while (u < 2048u) {
        unsigned raw;
        if (leader) { const unsigned one = 1u; asm volatile("global_atomic_add %0, %1, %2, off sc0" : "=v"(raw) : "v"(qhead), "v"(one) : "memory"); }
        const int qb = 15 - (int)(u >> 7), bh = (int)(u & 127u) >> 1, b = bh >> 3, h = bh & 7;
        unsigned un = 2048u; int t0n = 0, vsn = 0;
        if (u & 1u) attn_unit<true, ABL>(lds, ws, b, h, qb, wave, lane, dry, pre, t0p, vs0, raw, qw + 1 + par, un, t0n, vsn, qx);
        else attn_unit<false, ABL>(lds, ws, b, h, qb, wave, lane, dry, pre, t0p, vs0, raw, qw + 1 + par, un, t0n, vsn, qx);
        u = un; pre = true; t0p = t0n; vs0 = vsn; par ^= 1;
    }
    asm volatile("s_waitcnt vmcnt(0) lgkmcnt(0)" ::: "memory"); __syncthreads();
}

#define XB_TMO      128
#define XB_XCNT(j)  (256  + 64 * (j))
#define XB_XSUB(j)  (1280 + 64 * (j))
#define XB_XGEN(j)  (2304 + 64 * (j))
#define XB_TOP      3328
#define XB_TOPGEN   3392
#define XCD_BAR_WORDS 3456
#define XB_SPIN_CAP (1u << 18)
constexpr int CW_BAR = 4096;
__device__ __forceinline__ unsigned xb_ld(unsigned* p)              { return __hip_atomic_load(p, __ATOMIC_RELAXED, __HIP_MEMORY_SCOPE_AGENT); }
__device__ __forceinline__ unsigned xb_add(unsigned* p, unsigned v) { return __hip_atomic_fetch_add(p, v, __ATOMIC_RELAXED, __HIP_MEMORY_SCOPE_AGENT); }
__device__ __forceinline__ unsigned xb_xcc_id() { return (unsigned)__builtin_amdgcn_s_getreg((3 << 11) | 20) & 0xFu; }
#define XB_SPIN(cond, bar) do { unsigned _sp = 0; while (cond) { __builtin_amdgcn_s_sleep(1); \
    if ((++_sp & 255u) == 0u) { if (xb_ld(&(bar)[XB_TMO])) break; if (_sp > XB_SPIN_CAP) { atomicAdd(&(bar)[XB_TMO], 1u); break; } } } } while (0)
struct XcdBarrier { unsigned* bar; unsigned x; volatile LAS unsigned* st; };
__device__ __forceinline__ XcdBarrier xcd_barrier_post(unsigned* bar, volatile LAS unsigned* st) {
    XcdBarrier b; b.bar = bar; b.x = xb_xcc_id(); b.st = st;
    if (threadIdx.x == 0) (void)xb_add(&bar[XB_XCNT(b.x)], 1u);
    return b;
}
__device__ __forceinline__ void xcd_barrier_complete(unsigned* bar, unsigned x, unsigned& nloc, unsigned& nx) {
    const unsigned G = gridDim.x * gridDim.y * gridDim.z;
    unsigned sum, cnt, mine, sp = 0u;
    for (;;) {
        sum = 0u; cnt = 0u; mine = 0u;
#pragma unroll
        for (unsigned j = 0; j < 16; ++j) { const unsigned c = xb_ld(&bar[XB_XCNT(j)]); sum += c; cnt += (c > 0u) ? 1u : 0u; mine = (j == x) ? c : mine; }
        if (sum == G) break;
        __builtin_amdgcn_s_sleep(1);
        if ((++sp & 255u) == 0u) { if (xb_ld(&bar[XB_TMO])) break; if (sp > XB_SPIN_CAP) { atomicAdd(&bar[XB_TMO], 1u); break; } }
    }
    nloc = mine > 0u ? mine : 1u; nx = cnt > 0u ? cnt : 1u;
}
__device__ __forceinline__ void xcd_barrier(const XcdBarrier& b) {
    asm volatile("s_waitcnt vmcnt(0)" ::: "memory");
    __syncthreads();
    if (threadIdx.x == 0) {
        unsigned* bar = b.bar;
        __builtin_amdgcn_s_waitcnt(0);
        unsigned nloc = b.st[0], nx = b.st[1];
        if (nloc == 0u) { xcd_barrier_complete(bar, b.x, nloc, nx); b.st[0] = nloc; b.st[1] = nx; }
        const unsigned old = xb_add(&bar[XB_XSUB(b.x)], 1u);
        const unsigned gen = old / nloc;
        if (old + 1u == (gen + 1u) * nloc) {
            __builtin_amdgcn_fence(__ATOMIC_RELEASE, "agent");
            asm volatile("s_waitcnt vmcnt(0)" ::: "memory");
            const unsigned og = xb_add(&bar[XB_TOP], 1u);
            const unsigned tg = og / nx;
            if (og + 1u == (tg + 1u) * nx) xb_add(&bar[XB_TOPGEN], 1u);
            else XB_SPIN(xb_ld(&bar[XB_TOPGEN]) == tg, bar);
            __builtin_amdgcn_fence(__ATOMIC_ACQUIRE, "agent");
            xb_add(&bar[XB_XGEN(b.x)], 1u);
            asm volatile("s_waitcnt vmcnt(0)" ::: "memory");
        } else {
            XB_SPIN(xb_ld(&bar[XB_XGEN(b.x)]) == gen, bar);
            __builtin_amdgcn_fence(__ATOMIC_ACQUIRE, "agent");
            asm volatile("s_waitcnt vmcnt(0)" ::: "memory");
        }
    }
    __syncthreads();
}

__device__ __forceinline__ void scan_tile(unsigned char* ws, int bt, int lane) {
    asm volatile("" : "+v"(lane));
    const int tile = bt & 15; const size_t r0 = (size_t)bt * 256 + (size_t)lane * 4;
    const float* ts = WSA(float, WS_SMALL + SM_D) + (size_t)(bt - tile) * 16;
    f32x4 base0 = {0.f, 0.f, 0.f, 0.f}, base1 = base0;
    for (int j = 0; j < tile; ++j) { const f32x4* p = (const f32x4*)(ts + j * 16); base0 += p[0] + p[2]; base1 += p[1] + p[3]; }
    const f32x4* lf = (const f32x4*)(WSA(float, WS_SMALL + SM_LF) + r0 * 8);
    f32x4 v[4][2];
#pragma unroll
    for (int i = 0; i < 4; ++i) { v[i][0] = lf[2 * i]; v[i][1] = lf[2 * i + 1]; }
#pragma unroll
    for (int i = 1; i < 4; ++i) { v[i][0] += v[i - 1][0]; v[i][1] += v[i - 1][1]; }
    f32x4 p0 = v[3][0], p1 = v[3][1];
#pragma unroll
    for (int o = 1; o < 64; o <<= 1) {
#pragma unroll
        for (int j = 0; j < 4; ++j) { const float x0 = p0[j], x1 = p1[j];
            const int y0 = __builtin_amdgcn_ds_bpermute((lane - o) << 2, __builtin_bit_cast(int, x0)), y1 = __builtin_amdgcn_ds_bpermute((lane - o) << 2, __builtin_bit_cast(int, x1));
            if (lane >= o) { p0[j] = x0 + __builtin_bit_cast(float, y0); p1[j] = x1 + __builtin_bit_cast(float, y1); } } }
    const f32x4 e0 = base0 + (p0 - v[3][0]), e1 = base1 + (p1 - v[3][1]);
    if (lane < 16) { const int h = lane & 7, which = lane >> 3;
        const f32x4 t4 = *(const f32x4*)(WSA(float, WS_SMALL + SM_D + 65536) + (((size_t)which * 128 + bt) * 8 + h) * 4);
        WSA(float, WS_SMALL + SM_D + (which ? 20480 : 16384))[bt * 8 + h] = fmaxf(t4[0], t4[1]) + fmaxf(t4[2], t4[3]); }
    bf16_t* qa = WSA(bf16_t, WS_X + X_QA) + r0 * 64; bf16_t* ka = WSA(bf16_t, WS_X + X_KA) + ((size_t)(bt >> 4) * 8 * SEQ + (size_t)(bt & 15) * 256 + (size_t)lane * 4) * 8;
    unsigned one = 0x3f80u; asm volatile("" : "+v"(one));
#pragma unroll
    for (int i = 0; i < 4; ++i)
#pragma unroll
        for (int h = 0; h < 8; ++h) { const float D = ((h < 4) ? (e0[h & 3] + v[i][0][h & 3]) : (e1[h & 3] + v[i][1][h & 3])) * LOG2E;
            const unsigned d1 = f2bf(D); const float r1 = D - bf2f(d1); const unsigned d2 = f2bf(r1); const float r2 = r1 - bf2f(d2); const unsigned d3 = f2bf(r2);
            *(u32x4*)(qa + i * 64 + h * 8) = (u32x4){one | (one << 16), one | (d1 << 16), d2 | (d3 << 16), 0u};
            *(u32x4*)(ka + ((size_t)h * SEQ + i) * 8) = (u32x4){(d1 ^ 0x8000u) | ((d2 ^ 0x8000u) << 16), (d3 ^ 0x8000u) | (one << 16), one | (one << 16), 0u};
            if (i == 3 && (lane & 15) == 15) WSA(float, WS_SMALL + SM_D + 32768)[((size_t)(bt >> 4) * 8 + h) * 64 + (bt & 15) * 4 + (lane >> 4)] = D; }
}

__device__ __forceinline__ void pro_item(const float* __restrict__ src, const float* __restrict__ src2, const float* __restrict__ gain, const float* __restrict__ gain2, bf16_t* __restrict__ dst,
                                         const int K, const int Nsrc, const int Ndst, const int mode, LAS float* scr, const int item, const int lane, const float f8s = 0.f) {
    const int nblk = Ndst / 32, kb = item / nblk, nb = item % nblk, k0 = 64 * kb, n0 = 32 * nb;
    const int n = n0 + (lane & 31); int col; const float* sp = src;
    if (mode == 0) col = map_in(n); else if (mode == 1) col = map_uq(n); else if (mode == 2) col = map_ukv(n); else if (mode == 3) col = n;
    else { const int pn = n >> 8, w = n & 255; if (w < 128) col = pn * 128 + w; else { col = pn * 128 + (w - 128); sp = src2; } }
    float vals[32];
#pragma unroll
    for (int i = 0; i < 32; ++i) { const int k = k0 + 2 * i + (lane >> 5); vals[i] = col >= 0 ? sp[(size_t)k * Nsrc + col] : 0.f; }
#pragma unroll
    for (int i = 0; i < 32; ++i) { const int kk = 2 * i + (lane >> 5), k = k0 + kk;
        float g = 1.f; if (gain) g = (gain2 && k >= 512) ? gain2[k - 512] : gain[k];
        scr[kk * 33 + (lane & 31)] = vals[i] * g; }
    asm volatile("s_waitcnt lgkmcnt(0)" ::: "memory");
    const int c = lane & 7;
#pragma unroll
    for (int j = 0; j < 4; ++j) { const int nn = (lane >> 3) + 8 * j; const LAS float* sq = scr + (8 * c) * 33 + nn;
        if (f8s != 0.f) {
            int w0 = __builtin_amdgcn_cvt_pk_fp8_f32(sq[0 * 33] * f8s, sq[1 * 33] * f8s, 0, false); w0 = __builtin_amdgcn_cvt_pk_fp8_f32(sq[2 * 33] * f8s, sq[3 * 33] * f8s, w0, true);
            int w1 = __builtin_amdgcn_cvt_pk_fp8_f32(sq[4 * 33] * f8s, sq[5 * 33] * f8s, 0, false); w1 = __builtin_amdgcn_cvt_pk_fp8_f32(sq[6 * 33] * f8s, sq[7 * 33] * f8s, w1, true);
            *(u32x2*)((unsigned char*)dst + (size_t)(n0 + nn) * K + k0 + 8 * c) = (u32x2){(unsigned)w0, (unsigned)w1};
        } else {
        u32x4 o; o.x = pk2(sq[0 * 33], sq[1 * 33]); o.y = pk2(sq[2 * 33], sq[3 * 33]); o.z = pk2(sq[4 * 33], sq[5 * 33]); o.w = pk2(sq[6 * 33], sq[7 * 33]);
        *(u32x4*)(dst + (size_t)(n0 + nn) * K + k0 + 8 * c) = o; } }
    asm volatile("s_waitcnt lgkmcnt(0)" ::: "memory");
}
template <bool WO>
__device__ __forceinline__ void pro_win_i8(LAS unsigned char* lds, const float* __restrict__ src, const float* __restrict__ gain, const float* __restrict__ gain2, unsigned char* __restrict__ dst8, float* __restrict__ wcs, const int nb, const int wave, const int lane) {
    LAS float* scr = (LAS float*)(lds + wave * 16384); LAS float* red = (LAS float*)(lds + 8448);
    const int n0 = 32 * nb, n = n0 + (lane & 31), col = WO ? n : map_in(n), kh = lane >> 5; constexpr int NS = WO ? DM : IN_W;
    const float* gv = (WO && wave >= 4) ? gain2 - 512 : gain;
    float va[32], vb[32]; float mx = 0.f;
#pragma unroll
    for (int i = 0; i < 32; ++i) { const int k = 128 * wave + 2 * i + kh; va[i] = col >= 0 ? src[(size_t)k * NS + col] * gv[k] : 0.f; vb[i] = col >= 0 ? src[(size_t)(k + 64) * NS + col] * gv[k + 64] : 0.f; }
#pragma unroll
    for (int i = 0; i < 32; ++i) mx = fmaxf(mx, fmaxf(fabsf(va[i]), fabsf(vb[i])));
    mx = xmx32(mx);
    if (lane < 32) red[wave * 32 + lane] = mx;
    asm volatile("s_waitcnt lgkmcnt(0)" ::: "memory"); __syncthreads();
#pragma unroll
    for (int w = 0; w < 8; ++w) mx = fmaxf(mx, red[w * 32 + (lane & 31)]);
    const float inv = mx > 0.f ? 127.0f / mx : 0.f;
    if (wave == 0 && lane < 32) wcs[n] = mx * (1.0f / 127.0f);
#pragma unroll
    for (int h = 0; h < 2; ++h) {
#pragma unroll
        for (int i = 0; i < 32; ++i) scr[(2 * i + kh) * 33 + (lane & 31)] = __builtin_rintf((h ? vb[i] : va[i]) * inv);
        asm volatile("s_waitcnt lgkmcnt(0)" ::: "memory");
        const int c = lane & 7;
#pragma unroll
        for (int j = 0; j < 4; ++j) { const int nn = (lane >> 3) + 8 * j; const LAS float* sq = scr + (8 * c) * 33 + nn;
            const unsigned w0 = q4_i8(sq[0 * 33], sq[1 * 33], sq[2 * 33], sq[3 * 33], 1.0f), w1 = q4_i8(sq[4 * 33], sq[5 * 33], sq[6 * 33], sq[7 * 33], 1.0f);
            *(u32x2*)(dst8 + (size_t)(n0 + nn) * DM + 128 * wave + 64 * h + 8 * c) = (u32x2){w0, w1}; }
        asm volatile("s_waitcnt lgkmcnt(0)" ::: "memory");
    }
    __syncthreads();
}
__device__ __forceinline__ void prologue_phase(LAS unsigned char* lds, unsigned char* ws, const MkArgs& args, int vcu, int G, int wave, int lane) {
    LAS float* scr = (LAS float*)(lds + wave * 16384);
    const int gw = vcu * NWAVES + wave, NGW = G * NWAVES;
    constexpr int I_IN = 16 * 64, I_UQ = 4 * 24, I_UKV = 2 * 32, I_WO = 16 * 32, I_GU = 16 * 16, I_D = 4 * 32, I_L = I_IN + I_UQ + I_UKV + I_WO + NE * (I_GU + I_D);
    const float* attn_norm = args.in[2]; const float* w_in = args.in[3]; const float* q_norm = args.in[5]; const float* w_uq = args.in[6]; const float* kv_norm = args.in[7]; const float* w_ukv = args.in[8];
    const float* fox_on = args.in[9]; const float* mla_on = args.in[10]; const float* w_o = args.in[11]; const float* ffn_norm = args.in[12]; const float* w_group = args.in[13]; const float* w_router = args.in[14];
    const float* w_gate = args.in[15]; const float* w_up = args.in[16]; const float* w_down = args.in[17];
    if (vcu < DEPTH * (IN_WP / 32)) { const int l = vcu / (IN_WP / 32), nb = vcu % (IN_WP / 32);
        pro_win_i8<false>(lds, w_in + (size_t)l * DM * IN_W, attn_norm + l * DM, nullptr, ws + WS_WIN + (size_t)l * IN_WP * DM, WSA(float, WS_SMALL + SM_WCS) + l * IN_WP, nb, wave, lane); }
    else if (vcu < DEPTH * (IN_WP / 32) + DEPTH * (DM / 32)) { const int j = vcu - DEPTH * (IN_WP / 32), l = j / (DM / 32), nb = j % (DM / 32);
        pro_win_i8<true>(lds, w_o + (size_t)l * DM * DM, fox_on + l * FW, mla_on + l * MW, ws + WS_WO + (size_t)l * DM * DM, WSA(float, WS_SMALL + SM_WCS2) + l * DM, nb, wave, lane); }
#pragma unroll 1
    for (int it = gw; it < DEPTH * I_L; it += NGW) {
        const int l = it / I_L; int r = it % I_L;
        if (r < I_IN) continue; r -= I_IN;
        if (r < I_UQ) { pro_item(w_uq + (size_t)l * QL * 768, nullptr, q_norm + l * QL, nullptr, WSA(bf16_t, WS_WUQ) + (size_t)l * 768 * QL, QL, 768, 768, 1, scr, r, lane); continue; } r -= I_UQ;
        if (r < I_UKV) { pro_item(w_ukv + (size_t)l * KVL * 1024, nullptr, kv_norm + l * KVL, nullptr, WSA(bf16_t, WS_WUKV) + (size_t)l * 1024 * KVL, KVL, 1024, 1024, 2, scr, r, lane); continue; } r -= I_UKV;
        if (r < I_WO) continue; r -= I_WO;
        if (r < NE * I_GU) { const size_t le = (size_t)l * NE + r / I_GU;
            pro_item(w_gate + le * DM * DE, w_up + le * DM * DE, ffn_norm + l * DM, nullptr, (bf16_t*)(ws + WS_WGU + le * 512 * DM), DM, DE, 512, 4, scr, r % I_GU, lane, F8_WGU); continue; } r -= NE * I_GU;
        { const size_t le = (size_t)l * NE + r / I_D;
          pro_item(w_down + le * DE * DM, nullptr, nullptr, nullptr, (bf16_t*)(ws + WS_WD + le * DM * DE), DE, DM, DM, 3, scr, r % I_D, lane, F8_WD); }
    }
    const int gt = gw * 64 + lane, NGT = NGW * 64;
    for (int i = gt; i < DEPTH * (WR3_BYTES / 2); i += NGT) {
        const int l = i / (WR3_BYTES / 2), x = i % (WR3_BYTES / 2), e = x & 7, ln = (x >> 3) & 63, f = x >> 9, cb = f % 3, t = (f / 3) % 3, j = f / 9;
        const int k = 32 * j + 8 * (ln >> 4) + e, c = 16 * cb + (ln & 15);
        float v = 0.f; if (c < 8) v = w_group[((size_t)l * DM + k) * NG + c]; else if (c < 40) v = w_router[((size_t)l * DM + k) * NE + (c - 8)];
        v *= ffn_norm[l * DM + k];
        const float hi = bf2f(f2bf(v)), r1 = v - hi, mid = bf2f(f2bf(r1)), lo = r1 - mid;
        ((bf16_t*)(ws + WS_WR))[i] = (bf16_t)f2bf(t == 0 ? hi : (t == 1 ? mid : lo)); }
    for (int i = gt; i < T * 16; i += NGT) { const int t = i >> 4, j = i & 15;
        const float inv = powf(10000.0f, -(float)j / 16.0f); const float ang = (float)args.pos[t] * inv;
        WSA(float2, WS_ROPE)[i] = make_float2(cosf(ang), sinf(ang)); }
    for (int row = 2 * gw; row < T; row += 2 * NGW) {
        const f32x4* xr = (const f32x4*)(args.x + (size_t)row * DM) + lane;
        float s0 = 0.f, s1 = 0.f; f32x4 v[8];
#pragma unroll
        for (int j = 0; j < 8; ++j) v[j] = xr[64 * j];
#pragma unroll
        for (int j = 0; j < 4; ++j) { s0 += v[j].x * v[j].x + v[j].y * v[j].y + v[j].z * v[j].z + v[j].w * v[j].w; s1 += v[4 + j].x * v[4 + j].x + v[4 + j].y * v[4 + j].y + v[4 + j].z * v[4 + j].z + v[4 + j].w * v[4 + j].w; }
        s0 = wave_sum(s0); s1 = wave_sum(s1);
        float m0 = 0.f, m1 = 0.f;
#pragma unroll
        for (int j = 0; j < 4; ++j) { m0 = fmaxf(fmaxf(m0, fmaxf(fabsf(v[j].x), fabsf(v[j].y))), fmaxf(fabsf(v[j].z), fabsf(v[j].w))); m1 = fmaxf(fmaxf(m1, fmaxf(fabsf(v[4 + j].x), fabsf(v[4 + j].y))), fmaxf(fabsf(v[4 + j].z), fabsf(v[4 + j].w))); }
        m0 = wave_max0(m0); m1 = wave_max0(m1);
        const float i0 = m0 > 0.f ? 127.0f / m0 : 0.f, i1 = m1 > 0.f ? 127.0f / m1 : 0.f;
        { unsigned* a8 = (unsigned*)(ws + WS_Z + Z_A8 + (size_t)row * DM) + lane;
#pragma unroll
          for (int j = 0; j < 8; ++j) a8[64 * j] = q4_i8(v[j].x, v[j].y, v[j].z, v[j].w, j < 4 ? i0 : i1); }
        if (lane == 0) { WSA(float, WS_SMALL + SM_RSTD)[row] = m0 * (1.0f / 127.0f) / sqrtf(s0 * (1.0f / DM) + EPS); WSA(float, WS_SMALL + SM_RSTD)[row + 1] = m1 * (1.0f / 127.0f) / sqrtf(s1 * (1.0f / DM) + EPS); }
    }
}

constexpr int PROBE_ABL = 0;
constexpr int PROBE_PH = -1;
constexpr int PH_PRO = 0, PH_PER_LAYER = 8, PH_TOTAL = 1 + PH_PER_LAYER * DEPTH;
enum { PL_INPROJ = 0, PL_UP = 1, PL_ATTN = 2, PL_WO = 3, PL_ROUTE = 4, PL_GU = 5, PL_DOWN = 6, PL_COMB = 7 };

__global__ void __launch_bounds__(NWAVES * 64, 2) mk_fwd(MkArgs args) {
    extern __shared__ __attribute__((aligned(16))) unsigned char lds_raw[];
    LAS unsigned char* lds = (LAS unsigned char*)lds_raw;
    volatile LAS unsigned* MISC = (volatile LAS unsigned*)(lds + MISC_OFF);
    const int tid = threadIdx.x; const int wave_k = __builtin_amdgcn_readfirstlane(tid >> 6);
    const int G = gridDim.x; const int bx = blockIdx.x;
    unsigned char* const ws_k = args.ws;
    unsigned* ctl = (unsigned*)(ws_k + WS_CTL);
    for (int u = tid; u < (LDS_BYTES - RING_BYTES) / 4; u += NWAVES * 64) ((LAS unsigned*)(lds + RING_BYTES))[u] = 0u;
    __syncthreads();
    const int lo = args.ph_lo, hi = args.ph_hi;
    const bool multi = (hi - lo) > 1;
    XcdBarrier bar; bar.bar = ctl + CW_BAR; bar.x = 0; bar.st = nullptr;
    if (multi) bar = xcd_barrier_post(ctl + CW_BAR, MISC + 8);
#define PHASE_LOCALS int lane; asm volatile("v_mbcnt_lo_u32_b32 %0, -1, 0\n\tv_mbcnt_hi_u32_b32 %0, -1, %0" : "=v"(lane)); size_t zoff = 0; asm volatile("" : "+s"(zoff)); unsigned char* const ws = ws_k + zoff; int bxo = blockIdx.x; asm volatile("" : "+s"(bxo)); const int vcu = (G % 8 == 0) ? (bxo % 8) * (G / 8) + bxo / 8 : bxo
#define IN(k) (pk == (k))
#define SEAM(k) do { } while (0)
    bool probed = false;
#pragma unroll 1
    for (int ph = lo; ph < hi; ++ph) {
        if (ph == PH_PRO) { { PHASE_LOCALS; const int wave = wave_k; prologue_phase(lds, ws, args, vcu, G, wave, lane); } if (ph + 1 < hi) xcd_barrier(bar); if (PROBE_PH == 0 && !probed) { probed = true; --ph; } continue; }
        const int wave = wave_k; const bool dry = (PROBE_PH > 0 && ph == PROBE_PH && !probed);
        int l = (ph - 1) / PH_PER_LAYER; const int pk = (ph - 1) % PH_PER_LAYER; asm volatile("" : "+s"(l)); const int pb = 0;
#ifndef DBG_MASK
#define DBG_MASK 0xff
#endif
        if (((DBG_MASK >> PL_INPROJ) & 1) && IN(pb + PL_INPROJ)) {
            PHASE_LOCALS;
            pg8::DenseOrder S; S.init(ws + WS_Z + Z_A8, ws + WS_WIN + (size_t)l * IN_WP * DM, T, IN_WP, DM / 2, G, bxo); S.rot = (G == 256) ? 2 : 0;
            EpiInProj E{ws, args.b_f + l * FH, WSA(float, WS_SMALL + SM_WCS) + l * IN_WP};
            pg8::gemm_phase<EpiInProj, pg8::DenseOrder>(lds, wave, DM / 2, S, E, (dry && PROBE_ABL < 3) ? PROBE_ABL : 0);
        }
        SEAM(pb + PL_INPROJ);
        if (((DBG_MASK >> PL_UP) & 1) && IN(pb + PL_UP)) {
            PHASE_LOCALS;
            { const int sblk = (G >= 144) ? bxo - 128 : vcu; const int gw = sblk * NWAVES + wave; if (sblk >= 0 && gw < BATCH * 16) scan_tile(ws, gw, lane); }
#ifndef NO_Q
            { pg8::DenseOrder S; S.init(ws + WS_X + X_CQ, WSA(bf16_t, WS_WUQ) + (size_t)l * 768 * QL, T, 768, QL, G, bxo);
              EpiUpQ E{ws}; pg8::gemm_phase<EpiUpQ, pg8::DenseOrder>(lds, wave, QL, S, E); }
#endif
#ifndef NO_KV
            { pg8::DenseOrder S; S.init(ws + WS_X + X_CKV, WSA(bf16_t, WS_WUKV) + (size_t)l * 1024 * KVL, T, 1024, KVL, G, bxo);
              EpiUpKV E{ws}; pg8::gemm_phase<EpiUpKV, pg8::DenseOrder>(lds, wave, KVL, S, E); }
#endif
        }
        SEAM(pb + PL_UP);
        if (((DBG_MASK >> PL_ATTN) & 1) && IN(pb + PL_ATTN)) {
            PHASE_LOCALS;
            unsigned* qhead = ctl + CW_ATTQ + 64 * (dry ? 2 : l);
            if (PROBE_ABL != 0 && dry) attn_phase<PROBE_ABL>(lds, ws, qhead, wave, lane, true); else attn_phase<0>(lds, ws, qhead, wave, lane, dry);
        }
        SEAM(pb + PL_ATTN);
        if (((DBG_MASK >> PL_WO) & 1) && IN(pb + PL_WO)) {
            PHASE_LOCALS;
            pg8::DenseOrder S; S.init(ws + WS_AO, ws + WS_WO + (size_t)l * DM * DM, T, DM, DM / 2, G, bxo);
            EpiWo E{ws, l == 0 ? args.x : nullptr, WSA(float, WS_SMALL + SM_WCS2) + l * DM};
            pg8::gemm_phase<EpiWo, pg8::DenseOrder>(lds, wave, DM / 2, S, E);
        }
        SEAM(pb + PL_WO);
        if (((DBG_MASK >> PL_ROUTE) & 1) && IN(pb + PL_ROUTE)) {
            PHASE_LOCALS;
            for (int rb = vcu; rb < T / 128; rb += G)
                route_tile(lds, ws, args.H, ctl + CW_CNT + 2048 * (dry ? 2 : l), l, wave < 4 ? rb * 128 + wave * 32 : -1, wave, lane, dry);
        }
        SEAM(pb + PL_ROUTE);
        if (((DBG_MASK >> PL_GU) & 1) && IN(pb + PL_GU)) {
            PHASE_LOCALS;
            moe_build_tb(lds, ctl + CW_CNT + 2048 * l, wave, lane);
            MoeOrder<2, true> S; S.tb = (LAS const int*)(lds + TB_OFF); S.A = (const char*)(ws + WS_X + X_H8); S.Bt = (const char*)(ws + WS_WGU + (size_t)l * NE * 512 * DM);
            S.list = WSA(unsigned, WS_SMALL + SM_LIST); S.K = DM / 2; S.G = G; S.c = bxo; S.bstride = (size_t)512 * DM;
            EpiGU E{ws, (LAS const int*)(lds + TB_OFF)};
            pg8::gemm_phase<EpiGU, MoeOrder<2, true>>(lds, wave, DM / 2, S, E);
        }
        SEAM(pb + PL_GU);
        if (((DBG_MASK >> PL_DOWN) & 1) && IN(pb + PL_DOWN)) {
            PHASE_LOCALS;
            moe_build_tb(lds, ctl + CW_CNT + 2048 * l, wave, lane);
            MoeOrder<4, false> S; S.tb = (LAS const int*)(lds + TB_OFF); S.A = (const char*)(ws + WS_Z + Z_HE); S.Bt = (const char*)(ws + WS_WD + (size_t)l * NE * DM * DE);
            S.list = nullptr; S.K = DE / 2; S.G = G; S.c = bxo; S.bstride = (size_t)DM * DE;
            EpiDown E{ws, (LAS const int*)(lds + TB_OFF)};
            pg8::gemm_phase<EpiDown, MoeOrder<4, false>>(lds, wave, DE / 2, S, E);
        }
        SEAM(pb + PL_DOWN);
        if (((DBG_MASK >> PL_COMB) & 1) && IN(pb + PL_COMB)) {
            PHASE_LOCALS;
            moe_build_tb(lds, ctl + CW_CNT + 2048 * l, wave, lane);
            for (int row = vcu * NWAVES + wave; row < T; row += G * NWAVES) combine_row(ws, args.H, args.final_norm, l == DEPTH - 1, row, lane, dry, (LAS const int*)(lds + TB_OFF));
        }
        SEAM(pb + PL_COMB);
        if (ph + 1 < hi) xcd_barrier(bar);
        if (PROBE_PH > 0 && ph == PROBE_PH && !probed) { probed = true; --ph; }
    }
#undef IN
#undef SEAM
}
static int g_grid = 0;
static void launch_mk(MkArgs a, int lo, int hi, hipStream_t s) { a.ph_lo = lo; a.ph_hi = hi; hipLaunchKernelGGL(mk_fwd, dim3(g_grid), dim3(NWAVES * 64), LDS_BYTES, s, a); }
extern "C" void kernel_launch(void* const* d_in, const int* in_sizes, int n_in, void* d_out, int out_size, void* d_ws, size_t ws_size, hipStream_t stream) {
    if (n_in != 19 || out_size != T * DM || ws_size < WS_END) { fprintf(stderr, "kernel_launch: unexpected shapes (n_in %d out %d ws %zu)\n", n_in, out_size, ws_size); return; }
    const float* x = (const float*)d_in[0]; const int* pos = (const int*)d_in[1];
    const float* attn_norm = (const float*)d_in[2]; const float* w_in = (const float*)d_in[3]; const float* b_f = (const float*)d_in[4];
    const float* q_norm = (const float*)d_in[5]; const float* w_uq = (const float*)d_in[6]; const float* kv_norm = (const float*)d_in[7]; const float* w_ukv = (const float*)d_in[8];
    const float* fox_on = (const float*)d_in[9]; const float* mla_on = (const float*)d_in[10]; const float* w_o = (const float*)d_in[11];
    const float* ffn_norm = (const float*)d_in[12]; const float* w_group = (const float*)d_in[13]; const float* w_router = (const float*)d_in[14];
    const float* w_gate = (const float*)d_in[15]; const float* w_up = (const float*)d_in[16]; const float* w_down = (const float*)d_in[17]; const float* final_norm = (const float*)d_in[18];
    unsigned char* ws = (unsigned char*)d_ws;
    if (g_grid == 0) {
        int dev = 0, cus = 0;
        if (hipGetDevice(&dev) != hipSuccess || hipDeviceGetAttribute(&cus, hipDeviceAttributeMultiprocessorCount, dev) != hipSuccess) { fprintf(stderr, "kernel_launch: device query failed\n"); return; }
        if (hipFuncSetAttribute((const void*)mk_fwd, hipFuncAttributeMaxDynamicSharedMemorySize, LDS_BYTES) != hipSuccess) { fprintf(stderr, "kernel_launch: hipFuncSetAttribute failed\n"); return; }
        g_grid = cus;
    }
    (void)hipMemsetAsync(ws + WS_CTL, 0, 65536, stream);
    MkArgs ma{}; ma.x = x; ma.pos = pos; ma.b_f = b_f; ma.final_norm = final_norm; for (int i = 0; i < 19; ++i) ma.in[i] = (const float*)d_in[i]; ma.H = (float*)d_out; ma.ws = ws;
    launch_mk(ma, 0, PH_TOTAL, stream);
}
```

```cpp
#include <hip/hip_runtime.h>
#include <cstdio>
#include <cstdint>
#include <cmath>

typedef unsigned short bf16_t;
typedef unsigned u32x4 __attribute__((ext_vector_type(4)));
typedef float f32x4 __attribute__((ext_vector_type(4)));

constexpr int BATCH = 8, SEQ = 4096, T = BATCH * SEQ, DM = 1024, DEPTH = 2;
constexpr int FH = 8, FD = 64, FW = 512;
constexpr int MH = 8, NOPE = 64, ROPE = 32, MDK = 96, MV = 64, MW = 512;
constexpr int QL = 256, KVL = 128;
constexpr int IN_W = 1960, IN_WP = 2048;
constexpr int NG = 8, EPG = 4, NE = 32, DE = 256;
constexpr int APAD = 73728;
constexpr float EPS = 1e-6f;
constexpr float LOG2E = 1.4426950408889634f;
constexpr float C2F = 0.125f * LOG2E;
constexpr float C2M = 0.10206207261596575f * LOG2E;
constexpr int RW = 48;

constexpr size_t MiB = 1u << 20;
constexpr size_t WS_CTL = 0;
constexpr size_t WS_WIN = 1 * MiB;
constexpr size_t WS_WUQ = 9 * MiB;
constexpr size_t WS_WUKV = 10 * MiB;
constexpr size_t WS_WR = 11 * MiB;
constexpr size_t WS_WO = 12 * MiB;
constexpr size_t WS_WGU = 16 * MiB;
constexpr size_t WS_WD = 80 * MiB;
constexpr size_t WS_ROPE = 112 * MiB;
constexpr size_t WS_SMALL = 116 * MiB;
constexpr size_t WS_HB = 124 * MiB;
constexpr size_t WS_X = 188 * MiB;
constexpr size_t WS_Z = 316 * MiB;
constexpr size_t WS_AO = 444 * MiB;
constexpr size_t WS_END = 508 * MiB;
constexpr size_t SM_RSTD = 0;
constexpr size_t SM_RSTD2 = 128 * 1024;
constexpr size_t SM_SSQQ = 256 * 1024;
constexpr size_t SM_SSQKV = 768 * 1024;
constexpr size_t SM_LF = 1280 * 1024;
constexpr size_t SM_D = 2304 * 1024;
constexpr size_t SM_GATE = 3328 * 1024;
constexpr size_t SM_LIST = 3584 * 1024;
constexpr size_t SM_TSLOT = 7680 * 1024;
constexpr size_t X_FQ = 0, X_FK = 32 * MiB, X_FV = 64 * MiB, X_CQ = 96 * MiB, X_CKV = 112 * MiB, X_KR = 120 * MiB;
constexpr size_t X_Y0 = 0, X_Y1 = 64 * MiB;
constexpr size_t X_YT = 0;
constexpr size_t Z_QM = 0, Z_KM = 48 * MiB, Z_KR = 80 * MiB, Z_VM = 96 * MiB;
constexpr size_t Z_HE = 0;
constexpr int CW_CNT = 8192;

__device__ __forceinline__ unsigned f2bf(float f) { unsigned u = __builtin_bit_cast(unsigned, f); return (u + 0x7fffu + ((u >> 16) & 1u)) >> 16; }
__device__ __forceinline__ float bf2f(unsigned h) { return __builtin_bit_cast(float, h << 16); }
__device__ __forceinline__ unsigned pk2(float lo, float hi) { return f2bf(lo) | (f2bf(hi) << 16); }
__device__ __forceinline__ float xadd32(float v) { const unsigned a = __builtin_bit_cast(unsigned, v); auto r = __builtin_amdgcn_permlane32_swap(a, a, false, false); const unsigned x = r[0], y = r[1]; return __builtin_bit_cast(float, x) + __builtin_bit_cast(float, y); }
__device__ __forceinline__ float xadd16(float v) { const unsigned a = __builtin_bit_cast(unsigned, v); auto r = __builtin_amdgcn_permlane16_swap(a, a, false, false); const unsigned x = r[0], y = r[1]; return __builtin_bit_cast(float, x) + __builtin_bit_cast(float, y); }
__device__ __forceinline__ float xchg32(float v, bool lower_half) { const unsigned a = __builtin_bit_cast(unsigned, v); auto r = __builtin_amdgcn_permlane32_swap(a, a, false, false); const unsigned x = r[0], y = r[1]; return __builtin_bit_cast(float, lower_half ? y : x); }
template <int CTRL> __device__ __forceinline__ float dppf(float v) { return __builtin_bit_cast(float, __builtin_amdgcn_update_dpp(0u, __builtin_bit_cast(unsigned, v), CTRL, 0xf, 0xf, true)); }
__device__ __forceinline__ float wave_sum(float v) {
    v += dppf<0xB1>(v); v += dppf<0x4E>(v); v += dppf<0x141>(v); v += dppf<0x140>(v);
    v = xadd16(v); v = xadd32(v);
    return v;
}
__device__ __forceinline__ float dot_bf16(const bf16_t* a, const bf16_t* b, int K) {
    float acc = 0.f;
    for (int k = 0; k < K; k += 8) {
        const u32x4 va = *(const u32x4*)(a + k), vb = *(const u32x4*)(b + k);
#pragma unroll
        for (int j = 0; j < 4; ++j) {
            acc += bf2f(va[j] & 0xffffu) * bf2f(vb[j] & 0xffffu);
            acc += bf2f(va[j] >> 16) * bf2f(vb[j] >> 16);
        }
    }
    return acc;
}

__device__ __forceinline__ int map_in(int n) {
    if (n < 1536) return n;
    if (n < 1792) return 1544 + (n - 1536);
    if (n < 1920) return 1800 + (n - 1792);
    if (n < 1952) return 1928 + (n - 1920);
    if (n < 1960) return 1536 + (n - 1952);
    return -1;
}
__device__ __forceinline__ int map_uq(int n) { return n < 512 ? (n >> 6) * 96 + (n & 63) : ((n - 512) >> 5) * 96 + 64 + ((n - 512) & 31); }
__device__ __forceinline__ int map_ukv(int n) { return n < 512 ? (n >> 6) * 128 + (n & 63) : ((n - 512) >> 6) * 128 + 64 + ((n - 512) & 63); }
__device__ __forceinline__ int map_id(int n) { return n; }

#define LAS __attribute__((address_space(3)))
#define GAS __attribute__((address_space(1)))
typedef short bf16x8 __attribute__((ext_vector_type(8)));
typedef float f32x2 __attribute__((ext_vector_type(2)));
typedef float f32x16 __attribute__((ext_vector_type(16)));
typedef unsigned u32x2 __attribute__((ext_vector_type(2)));
typedef int i32x4 __attribute__((ext_vector_type(4)));
typedef int i32x8 __attribute__((ext_vector_type(8)));
typedef long i64x2 __attribute__((ext_vector_type(2)));
constexpr size_t X_H8 = 96 * MiB;
constexpr float F8_WGU = 64.0f, F8_WD = 32.0f;
constexpr size_t Z_A8 = 48 * MiB;
constexpr size_t SM_WCS = 7936 * 1024;
__device__ __forceinline__ float xmx32(float v) { const unsigned a = __builtin_bit_cast(unsigned, v); auto r = __builtin_amdgcn_permlane32_swap(a, a, false, false); const unsigned x = r[0], y = r[1]; return fmaxf(__builtin_bit_cast(float, x), __builtin_bit_cast(float, y)); }
__device__ __forceinline__ float xmx16(float v) { const unsigned a = __builtin_bit_cast(unsigned, v); auto r = __builtin_amdgcn_permlane16_swap(a, a, false, false); const unsigned x = r[0], y = r[1]; return fmaxf(__builtin_bit_cast(float, x), __builtin_bit_cast(float, y)); }
__device__ __forceinline__ float wave_max0(float v) {
    v = fmaxf(v, dppf<0xB1>(v)); v = fmaxf(v, dppf<0x4E>(v)); v = fmaxf(v, dppf<0x141>(v)); v = fmaxf(v, dppf<0x140>(v)); v = xmx16(v); v = xmx32(v); return v; }
constexpr float AO_C = 6.0f;
constexpr size_t SM_WCS2 = SM_WCS + 16384;
__device__ __forceinline__ unsigned q4_i8c(float a, float b, float c, float d, float inv) {
    const int q0 = (int)__builtin_rintf(__builtin_amdgcn_fmed3f(a * inv, -127.f, 127.f)), q1 = (int)__builtin_rintf(__builtin_amdgcn_fmed3f(b * inv, -127.f, 127.f));
    const int q2 = (int)__builtin_rintf(__builtin_amdgcn_fmed3f(c * inv, -127.f, 127.f)), q3 = (int)__builtin_rintf(__builtin_amdgcn_fmed3f(d * inv, -127.f, 127.f));
    return ((unsigned)q0 & 0xffu) | (((unsigned)q1 & 0xffu) << 8) | (((unsigned)q2 & 0xffu) << 16) | ((unsigned)q3 << 24); }
__device__ __forceinline__ unsigned q4_i8(float a, float b, float c, float d, float inv) {
    const int q0 = (int)__builtin_rintf(a * inv), q1 = (int)__builtin_rintf(b * inv), q2 = (int)__builtin_rintf(c * inv), q3 = (int)__builtin_rintf(d * inv);
    return ((unsigned)q0 & 0xffu) | (((unsigned)q1 & 0xffu) << 8) | (((unsigned)q2 & 0xffu) << 16) | ((unsigned)q3 << 24); }
constexpr int NWAVES = 8;
constexpr int RING_BYTES = 131072;
constexpr int MISC_OFF = RING_BYTES + 320;
constexpr int TB_OFF = RING_BYTES + 1024;
constexpr int TB_ORD = 80;
constexpr int LDS_BYTES = 147456;

constexpr size_t X_QA = 120 * MiB, X_KA = 124 * MiB;
namespace pg8 {
constexpr int BM = 256, BK = 64, HALF = 128, HTB = HALF * BK * 2, NXCD = 8, WGM = 8;
__device__ __forceinline__ int lds_byte(int r, int c) { const int st = (r >> 4) * 2 + (c >> 5), rr = r & 15, cc = c & 31, ob = rr * 64 + cc * 2; return st * 1024 + (ob ^ (((ob >> 9) & 1) << 5)); }
__device__ __forceinline__ void stage_rc(int b, int& R, int& C) { const int st = b / 1024, sb = b % 1024, swz = sb ^ (((sb >> 9) & 1) << 5); R = (st >> 1) * 16 + swz / 64; C = (st & 1) * 32 + (swz % 64) / 2; }
__device__ __forceinline__ int perm32(int rho) { const int n = rho >> 4, i = rho & 15; return 8 * (i >> 2) + 4 * n + (i & 3); }
__device__ __forceinline__ unsigned cvt_pk_bf16(float lo, float hi) { unsigned r; asm volatile("v_cvt_pk_bf16_f32 %0, %1, %2" : "=v"(r) : "v"(lo), "v"(hi)); return r; }

struct Unit { int pm, pn, e, tile, valid; const char* A; const char* B; };
struct LaneRC { int R[2], C[2]; };

struct DenseOrder {
    static constexpr bool GATHER = false; static constexpr bool RAGGED = false;
    __device__ __forceinline__ void lane_offs(const Unit&, const LaneRC&, unsigned (&)[2], unsigned (&)[2]) const {}
    const char* A; const char* Bt; int K, nM, nN, nwg, G, c, rot;
    __device__ __forceinline__ void init(const void* A_, const void* Bt_, int M, int N, int K_, int G_, int c_) { A = (const char*)A_; Bt = (const char*)Bt_; K = K_; nM = M / BM; nN = N / BM; nwg = nM * nN; G = G_; c = c_; rot = 0; }
    __device__ __forceinline__ bool next(int i, Unit& u) const {
        const long L = (long)i * G + c; if (L >= nwg) return false;
        int wgid = (int)L; { const int q = nwg / NXCD, r = nwg % NXCD, xcd = wgid % NXCD, off = wgid / NXCD; wgid = (xcd < r ? xcd * (q + 1) : r * (q + 1) + (xcd - r) * q) + off; }
        const int nig = WGM * nN, gid = wgid / nig, fm = gid * WGM, gsz = (nM - fm) < WGM ? (nM - fm) : WGM;
        u.pm = fm + ((wgid % nig) % gsz); u.pn = (wgid % nig) / gsz; u.e = 0; u.tile = 0; u.valid = BM;
        if (rot != 0 && (i & 2)) u.pn = (u.pn + rot) % nN;
        u.A = A + (size_t)u.pm * BM * K * 2; u.B = Bt + (size_t)u.pn * BM * K * 2;
        return true;
    }
};

template <class Epi, class Sched>
__device__ __forceinline__ void gemm_phase(LAS unsigned char* lds, const int wave_in, const int K_in, const Sched& S, const Epi& E, const int gabl = 0) {
    int K_ = K_in; asm volatile("" : "+s"(K_)); const int K = K_;
    int wave_o = wave_in; asm volatile("" : "+s"(wave_o));
    int tid_; asm volatile("v_mbcnt_lo_u32_b32 %0, -1, 0\n\tv_mbcnt_hi_u32_b32 %0, -1, %0" : "=v"(tid_)); tid_ += 64 * wave_o;
    const int tid = tid_, wid = wave_o, lane = tid & 63, wr = wid >> 2, wc = wid & 3, fr = lane & 15, fq = lane >> 4;
    const int nt = K / BK;
    LaneRC rc; unsigned voffA[2], voffB[2]; constexpr bool GA = Sched::GATHER;
#pragma unroll
    for (int i = 0; i < 2; ++i) { int R, C; stage_rc(tid * 16 + i * 8192, R, C); rc.R[i] = R; rc.C[i] = C; const int Rb = Epi::PERM ? ((R & ~31) + perm32(R & 31)) : R; voffA[i] = (unsigned)(R * K + C) * 2u; voffB[i] = (unsigned)(Rb * K + C) * 2u; }
    const size_t kstep = (size_t)(BK * 2);
    const size_t hstep = (size_t)HALF * K * 2;
    const unsigned ldsw = (unsigned)wid * 1024u;
    const int aoff = lds_byte(wr * 64 + fr, fq * 8), boff = lds_byte(wc * 32 + fr, fq * 8);
#define PG8_SA(b, h) (((b) * 2 + (h)) * HTB)
#define PG8_SB(b, h) ((4 + (b) * 2 + (h)) * HTB)
#define PG8_STAGE(bufoff, gbase, voff) do { _Pragma("unroll") for (int _i = 0; _i < 2; ++_i) \
        __builtin_amdgcn_global_load_lds((const unsigned*)((const char*)(gbase) + (voff)[_i]), (LAS unsigned*)(lds + (bufoff) + ldsw + _i * 8192), 16, 0, 0); } while (0)
#define PG8_LDA(dst, b, h) do { _Pragma("unroll") for (int m = 0; m < 4; ++m) _Pragma("unroll") for (int k = 0; k < 2; ++k) dst[m][k] = *(const LAS bf16x8*)(lds + PG8_SA(b, h) + aoff + m * 2048 + k * 1024); } while (0)
#define PG8_LDB(dst, b, h) do { _Pragma("unroll") for (int n = 0; n < 2; ++n) _Pragma("unroll") for (int k = 0; k < 2; ++k) dst[n][k] = *(const LAS bf16x8*)(lds + PG8_SB(b, h) + boff + n * 2048 + k * 1024); } while (0)
    unsigned f8one = 0x7f7f7f7fu; asm volatile("" : "+v"(f8one));
#ifndef RAG_SKIP
#define RAG_SKIP 1
#endif
#define PG8_MMA(ai, bj, At, Bt) do { if (RAG_SKIP && Sched::RAGGED && vr <= ((ai) ? HALF : 0)) break; if (gabl == 2) { asm volatile("" :: "v"(At[0][0]), "v"(At[3][1]), "v"(Bt[0][0]), "v"(Bt[1][1])); break; } __builtin_amdgcn_s_setprio(1); \
        if constexpr (Epi::F8) { _Pragma("unroll") for (int m = 0; m < 4; ++m) _Pragma("unroll") for (int n = 0; n < 2; ++n) { \
            const i32x8 b_ = __builtin_shufflevector(__builtin_bit_cast(i32x4, Bt[n][0]), __builtin_bit_cast(i32x4, Bt[n][1]), 0, 1, 2, 3, 4, 5, 6, 7); \
            const i32x8 a_ = __builtin_shufflevector(__builtin_bit_cast(i32x4, At[m][0]), __builtin_bit_cast(i32x4, At[m][1]), 0, 1, 2, 3, 4, 5, 6, 7); \
            asm volatile("v_mfma_scale_f32_16x16x128_f8f6f4 %0, %1, %2, %0, %3, %3 op_sel_hi:[0,0,0]" : "+v"(acc[ai][bj][m][n]) : "v"(b_), "v"(a_), "v"(f8one)); } } \
        else if constexpr (Epi::I8) { _Pragma("unroll") for (int m = 0; m < 4; ++m) _Pragma("unroll") for (int n = 0; n < 2; ++n) _Pragma("unroll") for (int k = 0; k < 2; ++k) \
        acc[ai][bj][m][n] = __builtin_bit_cast(f32x4, __builtin_amdgcn_mfma_i32_16x16x64_i8(__builtin_bit_cast(i32x4, Bt[n][k]), __builtin_bit_cast(i32x4, At[m][k]), __builtin_bit_cast(i32x4, acc[ai][bj][m][n]), 0, 0, 0)); } \
        else { _Pragma("unroll") for (int m = 0; m < 4; ++m) _Pragma("unroll") for (int n = 0; n < 2; ++n) _Pragma("unroll") for (int k = 0; k < 2; ++k) \
        acc[ai][bj][m][n] = __builtin_amdgcn_mfma_f32_16x16x32_bf16(Bt[n][k], At[m][k], acc[ai][bj][m][n], 0, 0, 0); } __builtin_amdgcn_s_setprio(0); } while (0)
#define PG8_WAIT_V(n) asm volatile("s_waitcnt vmcnt(" #n ")" ::: "memory")
#define PG8_WAIT_L(n) asm volatile("s_waitcnt lgkmcnt(" #n ")" ::: "memory")
#define PG8_BAR __builtin_amdgcn_s_barrier()
#define PG8_SCHED __builtin_amdgcn_sched_barrier(0)
#define PG8_STAGE_A(bufoff, base, h, V0, V1) do { if constexpr (GA) { if (h) PG8_STAGE(bufoff, base, V1); else PG8_STAGE(bufoff, base, V0); } else { PG8_STAGE(bufoff, (base) + ((h) ? hstep : 0), voffA); } } while (0)
    Unit cur, nxt; int ui = 0;
    unsigned cv0[2] = {0u, 0u}, cv1[2] = {0u, 0u}, nv0[2] = {0u, 0u}, nv1[2] = {0u, 0u};
    if (!S.next(0, cur)) return;
    S.lane_offs(cur, rc, cv0, cv1);
    f32x4 acc[2][2][4][2];
#pragma unroll
    for (int a = 0; a < 2; ++a)
#pragma unroll
        for (int b = 0; b < 2; ++b)
#pragma unroll
            for (int m = 0; m < 4; ++m)
#pragma unroll
                for (int n = 0; n < 2; ++n) acc[a][b][m][n] = (f32x4){0.f, 0.f, 0.f, 0.f};
    bf16x8 At[4][2], B0[2][2], B1[2][2];
    const char* cA = cur.A; const char* cB = cur.B;
    PG8_STAGE(PG8_SB(0, 0), cB, voffB); PG8_STAGE(PG8_SB(0, 1), cB + hstep, voffB); PG8_STAGE_A(PG8_SA(0, 0), cA, 0, cv0, cv1); PG8_STAGE_A(PG8_SA(0, 1), cA, 1, cv0, cv1);
    if (wr == 1) PG8_BAR;
    PG8_WAIT_V(2); PG8_BAR;
    PG8_STAGE(PG8_SB(1, 0), cB + kstep, voffB); PG8_STAGE_A(PG8_SA(1, 0), cA + kstep, 0, cv0, cv1); PG8_STAGE(PG8_SB(1, 1), cB + hstep + kstep, voffB);
    PG8_WAIT_V(6); PG8_BAR;
    for (;;) {
        const bool has_next = S.next(ui + 1, nxt);
        if (!has_next) nxt = cur;
        int vr = BM;
        if constexpr (Sched::RAGGED && RAG_SKIP) vr = cur.valid - wr * 64;
        if constexpr (GA) { if (has_next) S.lane_offs(nxt, rc, nv0, nv1); else { nv0[0] = cv0[0]; nv0[1] = cv0[1]; nv1[0] = cv1[0]; nv1[1] = cv1[1]; } }
        const char* nA = nxt.A; const char* nB = nxt.B;
#pragma unroll 1
        for (int t = 0; t < nt; t += 2) {
            const bool last = (t == nt - 2);
            const char* a1 = cA + (size_t)(t + 1) * kstep;
            const char* a2 = last ? nA : cA + (size_t)(t + 2) * kstep; const char* b2 = last ? nB : cB + (size_t)(t + 2) * kstep;
            const char* a3 = a2 + kstep; const char* b3 = b2 + kstep;
            unsigned x0[2], x1[2];
#pragma unroll
            for (int i = 0; i < 2; ++i) { x0[i] = last ? nv0[i] : cv0[i]; x1[i] = last ? nv1[i] : cv1[i]; }
            PG8_LDB(B0, 0, 0); PG8_LDB(B1, 0, 1); PG8_SCHED; PG8_LDA(At, 0, 0); PG8_STAGE_A(PG8_SA(1, 1), a1, 1, cv0, cv1);
            PG8_WAIT_V(8); PG8_WAIT_L(0); PG8_BAR; PG8_MMA(0, 0, At, B0); PG8_MMA(0, 1, At, B1); PG8_BAR; PG8_SCHED;
            PG8_LDA(At, 0, 1); PG8_STAGE(PG8_SB(0, 0), b2, voffB); PG8_STAGE(PG8_SB(0, 1), b2 + hstep, voffB); PG8_STAGE_A(PG8_SA(0, 0), a2, 0, x0, x1);
            PG8_WAIT_V(8); PG8_WAIT_L(0); PG8_BAR; PG8_MMA(1, 0, At, B0); PG8_MMA(1, 1, At, B1); PG8_BAR; PG8_SCHED;
            PG8_LDB(B0, 1, 0); PG8_LDB(B1, 1, 1); PG8_SCHED; PG8_LDA(At, 1, 0); PG8_STAGE_A(PG8_SA(0, 1), a2, 1, x0, x1);
            PG8_WAIT_V(8); PG8_WAIT_L(0); PG8_BAR; PG8_MMA(0, 0, At, B0); PG8_MMA(0, 1, At, B1); PG8_BAR; PG8_SCHED;
            PG8_LDA(At, 1, 1); PG8_STAGE(PG8_SB(1, 0), b3, voffB); PG8_STAGE(PG8_SB(1, 1), b3 + hstep, voffB); PG8_STAGE_A(PG8_SA(1, 0), a3, 0, x0, x1);
            PG8_WAIT_V(8); PG8_WAIT_L(0); PG8_BAR; PG8_MMA(1, 0, At, B0); PG8_MMA(1, 1, At, B1); PG8_BAR; PG8_SCHED;
        }
        if (wr == 0) PG8_BAR;
        if (gabl != 0) { _Pragma("unroll") for (int a = 0; a < 2; ++a) _Pragma("unroll") for (int b = 0; b < 2; ++b) _Pragma("unroll") for (int m = 0; m < 4; ++m) _Pragma("unroll") for (int n = 0; n < 2; ++n) asm volatile("" :: "v"(acc[a][b][m][n])); }
        else { if constexpr (Epi::F8) asm volatile("s_nop 15\n\ts_nop 15\n\ts_nop 15" ::: "memory");
          int fr_e = fr, fq_e = fq; asm volatile("" : "+v"(fr_e), "+v"(fq_e));
          E(acc, cur, wr, wc, fr_e, fq_e); }
        if (!has_next) break;
#pragma unroll
        for (int a = 0; a < 2; ++a)
#pragma unroll
            for (int b = 0; b < 2; ++b)
#pragma unroll
                for (int m = 0; m < 4; ++m)
#pragma unroll
                    for (int n = 0; n < 2; ++n) acc[a][b][m][n] = (f32x4){0.f, 0.f, 0.f, 0.f};
        cur = nxt; cA = nA; cB = nB; ++ui;
        if constexpr (GA) { cv0[0] = nv0[0]; cv0[1] = nv0[1]; cv1[0] = nv1[0]; cv1[1] = nv1[1]; }
        if (wr == 1) PG8_BAR;
    }
    PG8_WAIT_V(0);
    PG8_BAR;
#undef PG8_SA
#undef PG8_SB
#undef PG8_STAGE
#undef PG8_STAGE_A
#undef PG8_LDA
#undef PG8_LDB
#undef PG8_MMA
#undef PG8_WAIT_V
#undef PG8_WAIT_L
#undef PG8_BAR
#undef PG8_SCHED
}
}

struct MkArgs {
    const float* x; const int* pos; const float* b_f; const float* final_norm; const float* in[19];
    float* H; unsigned char* ws;
    int ph_lo, ph_hi;
};
#define WSA(type, off) ((type*)(ws + (off)))

typedef f32x4 Acc[2][2][4][2];
__device__ __forceinline__ u32x4 pack8(const f32x4 a, const f32x4 b, float s) {
    u32x4 w; w.x = pg8::cvt_pk_bf16(a[0] * s, a[1] * s); w.y = pg8::cvt_pk_bf16(a[2] * s, a[3] * s); w.z = pg8::cvt_pk_bf16(b[0] * s, b[1] * s); w.w = pg8::cvt_pk_bf16(b[2] * s, b[3] * s); return w;
}
__device__ __forceinline__ float sq8(const f32x4 a, const f32x4 b) { return (a[0] * a[0] + a[1] * a[1]) + (a[2] * a[2] + a[3] * a[3]) + (b[0] * b[0] + b[1] * b[1]) + (b[2] * b[2] + b[3] * b[3]); }
__device__ __forceinline__ void rotary8(f32x4& v0, f32x4& v1, const float2* cs8, int fq) {
    f32x4 p0, p1;
#pragma unroll
    for (int j = 0; j < 4; ++j) { p0[j] = xchg32(v0[j], fq < 2); p1[j] = xchg32(v1[j], fq < 2); }
    const float sg = fq < 2 ? -1.f : 1.f;
#pragma unroll
    for (int j = 0; j < 4; ++j) { const float2 c0 = cs8[j], c1 = cs8[4 + j]; v0[j] = v0[j] * c0.x + sg * p0[j] * c0.y; v1[j] = v1[j] * c1.x + sg * p1[j] * c1.y; }
}

__device__ __forceinline__ void ld8_rows_f32x4(f32x4 (&v)[8], const float* p) {
    asm volatile("global_load_dwordx4 %0, %8, off\n\tglobal_load_dwordx4 %1, %8, off offset:256\n\tglobal_load_dwordx4 %2, %8, off offset:512\n\tglobal_load_dwordx4 %3, %8, off offset:768\n\t"
                 "global_load_dwordx4 %4, %8, off offset:2048\n\tglobal_load_dwordx4 %5, %8, off offset:2304\n\tglobal_load_dwordx4 %6, %8, off offset:2560\n\tglobal_load_dwordx4 %7, %8, off offset:2816\n\ts_waitcnt vmcnt(0)"
                 : "=&v"(v[0]), "=&v"(v[1]), "=&v"(v[2]), "=&v"(v[3]), "=&v"(v[4]), "=&v"(v[5]), "=&v"(v[6]), "=&v"(v[7]) : "v"(p) : "memory");
}

struct EpiInProj {
    static constexpr bool PERM = true; static constexpr bool F8 = false; static constexpr bool I8 = true;
    unsigned char* ws; const float* b_f; const float* wcs;
    __device__ __forceinline__ void operator()(Acc& acc, const pg8::Unit& u, int wr, int wc, int fr, int fq) const {
        const int row0 = u.pm * 256 + wr * 64 + fr, pn = u.pn;
        { const float* cp = wcs + pn * 256 + wc * 32 + 8 * fq;
          const f32x4 c00 = *(const f32x4*)(cp), c01 = *(const f32x4*)(cp + 4), c10 = *(const f32x4*)(cp + 128), c11 = *(const f32x4*)(cp + 132);
#pragma unroll
          for (int ai = 0; ai < 2; ++ai)
#pragma unroll
              for (int m = 0; m < 4; ++m) {
                  acc[ai][0][m][0] = __builtin_convertvector(__builtin_bit_cast(i32x4, acc[ai][0][m][0]), f32x4) * c00; acc[ai][0][m][1] = __builtin_convertvector(__builtin_bit_cast(i32x4, acc[ai][0][m][1]), f32x4) * c01;
                  acc[ai][1][m][0] = __builtin_convertvector(__builtin_bit_cast(i32x4, acc[ai][1][m][0]), f32x4) * c10; acc[ai][1][m][1] = __builtin_convertvector(__builtin_bit_cast(i32x4, acc[ai][1][m][1]), f32x4) * c11; } }
        const float* rstd = WSA(float, WS_SMALL + SM_RSTD);
        float rsv[8];
#pragma unroll
        for (int i = 0; i < 8; ++i) rsv[i] = rstd[row0 + (i >> 2) * 128 + (i & 3) * 16];
        if (pn < 6) {
            bf16_t* base0 = WSA(bf16_t, WS_X + (size_t)(pn >> 1) * 32 * MiB) + (pn & 1) * 256 + wc * 32 + 8 * fq;
            float nmx0 = 0.f, nmx1 = 0.f;
#pragma unroll
            for (int ai = 0; ai < 2; ++ai)
#pragma unroll
                for (int m = 0; m < 4; ++m) {
                    const int row = row0 + ai * 128 + m * 16; const float sc = pn < 2 ? rsv[ai * 4 + m] * C2F : rsv[ai * 4 + m];
                    bf16_t* base = base0 + (size_t)row * 512;
                    *(u32x4*)(base) = pack8(acc[ai][0][m][0], acc[ai][0][m][1], sc); *(u32x4*)(base + 128) = pack8(acc[ai][1][m][0], acc[ai][1][m][1], sc);
                    if (pn < 4) { float s0 = sq8(acc[ai][0][m][0], acc[ai][0][m][1]) * sc * sc, s1 = sq8(acc[ai][1][m][0], acc[ai][1][m][1]) * sc * sc;
                        s0 = xadd16(s0); s0 = xadd32(s0); s1 = xadd16(s1); s1 = xadd32(s1); nmx0 = fmaxf(nmx0, s0); nmx1 = fmaxf(nmx1, s1); }
                }
            if (pn < 4) {
                nmx0 = fmaxf(nmx0, dppf<0xB1>(nmx0)); nmx0 = fmaxf(nmx0, dppf<0x4E>(nmx0)); nmx0 = fmaxf(nmx0, dppf<0x141>(nmx0)); nmx0 = fmaxf(nmx0, dppf<0x140>(nmx0));
                nmx1 = fmaxf(nmx1, dppf<0xB1>(nmx1)); nmx1 = fmaxf(nmx1, dppf<0x4E>(nmx1)); nmx1 = fmaxf(nmx1, dppf<0x141>(nmx1)); nmx1 = fmaxf(nmx1, dppf<0x140>(nmx1));
                if (fq == 0 && fr == 0) { float* tm = WSA(float, WS_SMALL + SM_D + 65536) + ((((size_t)(pn >> 1) * 128 + u.pm) * 8 + (pn & 1) * 4 + (wc >> 1)) * 2 + (wc & 1)) * 2 + wr;
                    tm[0] = nmx0; tm[8] = nmx1; }
            }
        } else if (pn == 6) {
#pragma unroll
            for (int ai = 0; ai < 2; ++ai)
#pragma unroll
                for (int m = 0; m < 4; ++m) {
                    const int row = row0 + ai * 128 + m * 16; const float rs = rsv[ai * 4 + m];
                    bf16_t* base = WSA(bf16_t, WS_X + X_CQ) + (size_t)row * QL + wc * 32 + 8 * fq;
                    *(u32x4*)(base) = pack8(acc[ai][0][m][0], acc[ai][0][m][1], rs); *(u32x4*)(base + 128) = pack8(acc[ai][1][m][0], acc[ai][1][m][1], rs);
                    float s = (sq8(acc[ai][0][m][0], acc[ai][0][m][1]) + sq8(acc[ai][1][m][0], acc[ai][1][m][1])) * rs * rs; s = xadd16(s); s = xadd32(s);
                    if (fq == 0) WSA(float, WS_SMALL + SM_SSQQ)[row * 4 + wc] = s;
                }
        } else {
            f32x4 lfs0 = {0.f, 0.f, 0.f, 0.f}, lfs1 = lfs0;
#pragma unroll
            for (int ai = 0; ai < 2; ++ai)
#pragma unroll
                for (int m = 0; m < 4; ++m) {
                    const int row = row0 + ai * 128 + m * 16; const float rs = rsv[ai * 4 + m];
                    *(u32x4*)(WSA(bf16_t, WS_X + X_CKV) + (size_t)row * KVL + wc * 32 + 8 * fq) = pack8(acc[ai][0][m][0], acc[ai][0][m][1], rs);
                    float s = sq8(acc[ai][0][m][0], acc[ai][0][m][1]) * rs * rs; s = xadd16(s); s = xadd32(s);
                    if (fq == 0) WSA(float, WS_SMALL + SM_SSQKV)[row * 4 + wc] = s;
                    if (wc == 0) {
                        f32x4 v0 = acc[ai][1][m][0] * rs, v1 = acc[ai][1][m][1] * rs;
                        float2 cs8[8]; const float2* cp = WSA(float2, WS_ROPE) + (size_t)row * 16 + 8 * (fq & 1);
#pragma unroll
                        for (int j = 0; j < 8; ++j) cs8[j] = cp[j];
                        rotary8(v0, v1, cs8, fq);
                        const u32x4 w = pack8(v0, v1, 1.f);
                        *(u32x4*)(WSA(bf16_t, WS_Z + Z_KR) + (size_t)row * ROPE + 8 * fq) = w;
                    } else if (wc == 1 && fq == 0) {
                        f32x4 o[2];
#pragma unroll
                        for (int n = 0; n < 2; ++n)
#pragma unroll
                            for (int j = 0; j < 4; ++j) { const float z = acc[ai][1][m][n][j] * rs + b_f[4 * n + j];
                                o[n][j] = fminf(z, 0.f) - 0.6931471805599453f * __builtin_amdgcn_logf(1.0f + __builtin_amdgcn_exp2f(-1.4426950408889634f * fabsf(z))); }
                        f32x4* lf = (f32x4*)(WSA(float, WS_SMALL + SM_LF) + (size_t)row * 8); lf[0] = o[0]; lf[1] = o[1];
                        lfs0 += o[0]; lfs1 += o[1];
                    }
                }
            if (wc == 1) {
#pragma unroll
                for (int j = 0; j < 4; ++j) { float a = lfs0[j], bq = lfs1[j];
                    a += dppf<0xB1>(a); a += dppf<0x4E>(a); a += dppf<0x141>(a); a += dppf<0x140>(a);
                    bq += dppf<0xB1>(bq); bq += dppf<0x4E>(bq); bq += dppf<0x141>(bq); bq += dppf<0x140>(bq);
                    lfs0[j] = a; lfs1[j] = bq; }
                if (fq == 0 && fr == 0) { f32x4* ts = (f32x4*)(WSA(float, WS_SMALL + SM_D) + ((size_t)u.pm * 2 + wr) * 8); ts[0] = lfs0; ts[1] = lfs1; }
            }
        }
    }
};
struct EpiUpQ {
    static constexpr bool PERM = true; static constexpr bool F8 = false; static constexpr bool I8 = false;
    unsigned char* ws;
    __device__ __forceinline__ void operator()(const Acc& acc, const pg8::Unit& u, int wr, int wc, int fr, int fq) const {
        const int row0 = u.pm * 256 + wr * 64 + fr, pn = u.pn;
        float rsv[8];
#pragma unroll
        for (int i = 0; i < 8; ++i) rsv[i] = 0.f;
        { f32x4 sp[8]; ld8_rows_f32x4(sp, WSA(float, WS_SMALL + SM_SSQQ) + (size_t)row0 * 4);
#pragma unroll
          for (int i = 0; i < 8; ++i) rsv[i] = ((sp[i][0] + sp[i][1]) + (sp[i][2] + sp[i][3])) * (1.0f / QL) + EPS; }
        if (pn < 2) {
            const int c0 = pn * 256 + wc * 32 + 8 * fq, c1 = c0 + 128;
            bf16_t* q0 = WSA(bf16_t, WS_Z + Z_QM) + (c0 >> 6) * MDK + (c0 & 63); bf16_t* q1 = WSA(bf16_t, WS_Z + Z_QM) + (c1 >> 6) * MDK + (c1 & 63);
#pragma unroll
            for (int ai = 0; ai < 2; ++ai)
#pragma unroll
                for (int m = 0; m < 4; ++m) { const size_t ro = (size_t)(row0 + ai * 128 + m * 16) * (MH * MDK); const float sc = C2M / sqrtf(rsv[ai * 4 + m]);
                    *(u32x4*)(q0 + ro) = pack8(acc[ai][0][m][0], acc[ai][0][m][1], sc); *(u32x4*)(q1 + ro) = pack8(acc[ai][1][m][0], acc[ai][1][m][1], sc); }
        } else {
#pragma unroll
            for (int ai = 0; ai < 2; ++ai)
#pragma unroll
                for (int m = 0; m < 4; ++m) {
                    asm volatile("" ::: "memory");
                    const int row = row0 + ai * 128 + m * 16; const float rs = 1.0f / sqrtf(rsv[ai * 4 + m]);
                    bf16_t* qm = WSA(bf16_t, WS_Z + Z_QM) + (size_t)row * (MH * MDK);
                    float2 cs8[8]; const float2* cp = WSA(float2, WS_ROPE) + (size_t)row * 16 + 8 * (fq & 1);
#pragma unroll
                    for (int j = 0; j < 8; ++j) cs8[j] = cp[j];
#pragma unroll
                    for (int bj = 0; bj < 2; ++bj) { f32x4 v0 = acc[ai][bj][m][0] * rs, v1 = acc[ai][bj][m][1] * rs;
                        rotary8(v0, v1, cs8, fq);
                        *(u32x4*)(qm + (4 * bj + wc) * MDK + NOPE + 8 * fq) = pack8(v0, v1, C2M); }
                }
        }
    }
};
struct EpiUpKV {
    static constexpr bool PERM = true; static constexpr bool F8 = false; static constexpr bool I8 = false;
    unsigned char* ws;
    __device__ __forceinline__ void operator()(const Acc& acc, const pg8::Unit& u, int wr, int wc, int fr, int fq) const {
        const int row0 = u.pm * 256 + wr * 64 + fr, pn = u.pn;
        float rsv[8];
#pragma unroll
        for (int i = 0; i < 8; ++i) rsv[i] = 0.f;
        { f32x4 sp[8]; ld8_rows_f32x4(sp, WSA(float, WS_SMALL + SM_SSQKV) + (size_t)row0 * 4);
#pragma unroll
          for (int i = 0; i < 8; ++i) rsv[i] = ((sp[i][0] + sp[i][1]) + (sp[i][2] + sp[i][3])) * (1.0f / KVL) + EPS; }
#pragma unroll
        for (int ai = 0; ai < 2; ++ai)
#pragma unroll
            for (int m = 0; m < 4; ++m) {
                asm volatile("" ::: "memory");
                const int row = row0 + ai * 128 + m * 16;
                const float rs = 1.0f / sqrtf(rsv[ai * 4 + m]);
#pragma unroll
                for (int bj = 0; bj < 2; ++bj) { const int c = (pn & 1) * 256 + bj * 128 + wc * 32 + 8 * fq;
                    bf16_t* dst = (pn < 2 ? WSA(bf16_t, WS_Z + Z_KM) : WSA(bf16_t, WS_Z + Z_VM)) + (size_t)row * MW + c;
                    *(u32x4*)dst = pack8(acc[ai][bj][m][0], acc[ai][bj][m][1], rs); }
            }
    }
};
struct EpiWo {
    static constexpr bool PERM = true; static constexpr bool F8 = false; static constexpr bool I8 = true;
    unsigned char* ws; const float* xsrc; const float* wcs;
    __device__ __forceinline__ void operator()(Acc& acc, const pg8::Unit& u, int wr, int wc, int fr, int fq) const {
        const int row0 = u.pm * 256 + wr * 64 + fr;
        { const float* cp = wcs + u.pn * 256 + wc * 32 + 8 * fq;
          const f32x4 c00 = *(const f32x4*)(cp) * (AO_C / 127.0f), c01 = *(const f32x4*)(cp + 4) * (AO_C / 127.0f), c10 = *(const f32x4*)(cp + 128) * (AO_C / 127.0f), c11 = *(const f32x4*)(cp + 132) * (AO_C / 127.0f);
#pragma unroll
          for (int ai = 0; ai < 2; ++ai)
#pragma unroll
              for (int m = 0; m < 4; ++m) {
                  acc[ai][0][m][0] = __builtin_convertvector(__builtin_bit_cast(i32x4, acc[ai][0][m][0]), f32x4) * c00; acc[ai][0][m][1] = __builtin_convertvector(__builtin_bit_cast(i32x4, acc[ai][0][m][1]), f32x4) * c01;
                  acc[ai][1][m][0] = __builtin_convertvector(__builtin_bit_cast(i32x4, acc[ai][1][m][0]), f32x4) * c10; acc[ai][1][m][1] = __builtin_convertvector(__builtin_bit_cast(i32x4, acc[ai][1][m][1]), f32x4) * c11; } }
        unsigned char* h8 = ws + WS_X + X_H8 + ((size_t)row0 + (fq & 1) * 16) * DM + u.pn * 256 + wc * 32 + 8 * (fq & 2);
#pragma unroll
        for (int ai = 0; ai < 2; ++ai)
#pragma unroll
            for (int mp = 0; mp < 2; ++mp) {
                asm volatile("" ::: "memory");
                unsigned xw[2][2], yw[2][2];
#pragma unroll
                for (int hh = 0; hh < 2; ++hh) { const int m = 2 * mp + hh; const int row = row0 + ai * 128 + m * 16;
#pragma unroll
                    for (int bj = 0; bj < 2; ++bj) { const size_t off = (size_t)row * DM + u.pn * 256 + bj * 128 + wc * 32 + 8 * fq;
                        f32x4 h0, h1;
                        if (xsrc) { h0 = *(const f32x4*)(xsrc + off); h1 = *(const f32x4*)(xsrc + off + 4); }
                        else { const u32x4 hv = *(const u32x4*)(WSA(bf16_t, WS_HB) + off);
                            h0 = (f32x4){bf2f(hv.x & 0xffffu), bf2f(hv.x >> 16), bf2f(hv.y & 0xffffu), bf2f(hv.y >> 16)}; h1 = (f32x4){bf2f(hv.z & 0xffffu), bf2f(hv.z >> 16), bf2f(hv.w & 0xffffu), bf2f(hv.w >> 16)}; }
                        h0 += acc[ai][bj][m][0]; h1 += acc[ai][bj][m][1];
                        *(u32x4*)(WSA(bf16_t, WS_HB) + off) = pack8(h0, h1, 1.f);
                        int w0 = __builtin_amdgcn_cvt_pk_fp8_f32(h0[0], h0[1], 0, false); w0 = __builtin_amdgcn_cvt_pk_fp8_f32(h0[2], h0[3], w0, true);
                        int w1 = __builtin_amdgcn_cvt_pk_fp8_f32(h1[0], h1[1], 0, false); w1 = __builtin_amdgcn_cvt_pk_fp8_f32(h1[2], h1[3], w1, true);
                        if (hh == 0) { xw[bj][0] = (unsigned)w0; xw[bj][1] = (unsigned)w1; } else { yw[bj][0] = (unsigned)w0; yw[bj][1] = (unsigned)w1; } } }
#pragma unroll
                for (int bj = 0; bj < 2; ++bj) {
                    auto r0 = __builtin_amdgcn_permlane16_swap(xw[bj][0], yw[bj][0], false, false); auto r1 = __builtin_amdgcn_permlane16_swap(xw[bj][1], yw[bj][1], false, false);
                    const unsigned a0_ = r0[0], b0_ = r0[1], a1_ = r1[0], b1_ = r1[1];
                    *(u32x4*)(h8 + (size_t)(ai * 128 + mp * 32) * DM + bj * 128) = (u32x4){a0_, a1_, b0_, b1_}; }
            }
    }
};

__device__ __forceinline__ void moe_build_tb(LAS unsigned char* lds, const unsigned* cnt, int wave, int lane) {
    if (wave == 0) {
        const int c = lane < NE ? (int)__hip_atomic_load(cnt + (lane & 31) * 64, __ATOMIC_RELAXED, __HIP_MEMORY_SCOPE_AGENT) : 0;
        const int nt = (c + 255) >> 8; int pre = nt;
#pragma unroll
        for (int o = 1; o < 64; o <<= 1) { const int v = __builtin_amdgcn_ds_bpermute((lane - o) << 2, pre); if (lane >= o) pre += v; }
        LAS int* tb = (LAS int*)(lds + TB_OFF);
        if (lane < NE) { tb[lane + 1] = pre; tb[40 + lane] = c; }
        if (lane == 0) tb[0] = 0;
        const int has = nt > 0 ? 1 : 0; int hp = has;
#pragma unroll
        for (int o = 1; o < 64; o <<= 1) { const int v = __builtin_amdgcn_ds_bpermute((lane - o) << 2, hp); if (lane >= o) hp += v; }
        const int base = pre - nt, pf = base - (hp - has), nfull = __builtin_amdgcn_readlane(pre, 63) - __builtin_amdgcn_readlane(hp, 63);
        const int key = has ? ((c - (nt - 1) * 256) << 5) + (31 - lane) : -1; int rank = 0;
#pragma unroll
        for (int o = 0; o < NE; ++o) rank += (__builtin_amdgcn_readlane(key, o) > key) ? 1 : 0;
        if (lane < NE) { for (int k = 0; k < nt - 1; ++k) tb[TB_ORD + pf + k] = (base + k) | (256 << 16); if (has) tb[TB_ORD + nfull + rank] = (base + nt - 1) | ((c - (nt - 1) * 256) << 16); }
    }
    asm volatile("s_waitcnt lgkmcnt(0)" ::: "memory"); __syncthreads();
}
template <int NPN, bool GATHER_>
struct MoeOrder {
    static constexpr bool GATHER = GATHER_; static constexpr bool RAGGED = true;
    LAS const int* tb; const char* A; const char* Bt; const unsigned* list; int K, G, c; size_t bstride;
    __device__ __forceinline__ bool next(int i, pg8::Unit& u) const {
        const int L = i * G + c, total = tb[NE] * NPN; if (L >= total) return false;
        const int w = __builtin_amdgcn_readfirstlane(tb[TB_ORD + L / NPN]), g = w & 0xffff, pn = L % NPN; int e = 0; u.valid = w >> 16;
        for (int j = 1; j < NE; ++j) e = (tb[j] <= g) ? j : e;
        u.pm = g; u.pn = pn; u.e = e; u.tile = g - tb[e];
        u.A = GATHER_ ? A : A + (size_t)g * 256 * K * 2;
        u.B = Bt + (size_t)e * bstride + (size_t)pn * 256 * K * 2;
        return true;
    }
    __device__ __forceinline__ void lane_offs(const pg8::Unit& u, const pg8::LaneRC& rc, unsigned (&v0)[2], unsigned (&v1)[2]) const {
        if constexpr (GATHER_) {
            const int cn = tb[40 + u.e]; const unsigned* le = list + (size_t)u.e * T;
#pragma unroll
            for (int i = 0; i < 2; ++i) {
                const int p0 = u.tile * 256 + rc.R[i], p1 = p0 + 128;
                const unsigned t0 = le[p0 < cn ? p0 : 0] >> 1, t1 = le[p1 < cn ? p1 : 0] >> 1;
                v0[i] = (t0 * (unsigned)K + (unsigned)rc.C[i]) * 2u; v1[i] = (t1 * (unsigned)K + (unsigned)rc.C[i]) * 2u;
            }
        }
    }
};
#define RAG_IF(ai) if ((ai) * 128 + wr * 64 < u.valid)
struct EpiGU {
    static constexpr bool PERM = true; static constexpr bool F8 = true; static constexpr bool I8 = false;
    unsigned char* ws; LAS const int* tb;
    __device__ __forceinline__ void operator()(const Acc& acc, const pg8::Unit& u, int wr, int wc, int fr, int fq) const {
        const int cn = tb[40 + u.e]; const unsigned* le = WSA(unsigned, WS_SMALL + SM_LIST) + (size_t)u.e * T;
        unsigned tokv[8]; float rsv[8];
#pragma unroll
        for (int i = 0; i < 8; ++i) { const int pos = u.tile * 256 + (i >> 2) * 128 + wr * 64 + (i & 3) * 16 + fr; tokv[i] = le[pos < cn ? pos : 0] >> 1; }
#pragma unroll
        for (int i = 0; i < 8; ++i) rsv[i] = WSA(float, WS_SMALL + SM_RSTD2)[tokv[i]];
        unsigned char* he = ws + WS_Z + Z_HE + ((size_t)u.pm * 256 + wr * 64 + fr + (fq & 1) * 16) * DE + u.pn * 128 + wc * 32 + 8 * (fq & 2);
#pragma unroll
        for (int ai = 0; ai < 2; ++ai) RAG_IF(ai)
#pragma unroll
            for (int mp = 0; mp < 2; ++mp) {
                unsigned xw[2], yw[2];
#pragma unroll
                for (int hh = 0; hh < 2; ++hh) { const int m = 2 * mp + hh; const float rs = rsv[ai * 4 + m] * (1.0f / F8_WGU);
                    f32x4 h0, h1;
#pragma unroll
                    for (int j = 0; j < 4; ++j) {
                        const float g0 = acc[ai][0][m][0][j] * rs, u0 = acc[ai][1][m][0][j] * rs, g1 = acc[ai][0][m][1][j] * rs, u1 = acc[ai][1][m][1][j] * rs;
                        h0[j] = g0 * __builtin_amdgcn_rcpf(1.0f + __expf(-g0)) * u0; h1[j] = g1 * __builtin_amdgcn_rcpf(1.0f + __expf(-g1)) * u1;
                    }
                    int w0 = __builtin_amdgcn_cvt_pk_fp8_f32(h0[0], h0[1], 0, false); w0 = __builtin_amdgcn_cvt_pk_fp8_f32(h0[2], h0[3], w0, true);
                    int w1 = __builtin_amdgcn_cvt_pk_fp8_f32(h1[0], h1[1], 0, false); w1 = __builtin_amdgcn_cvt_pk_fp8_f32(h1[2], h1[3], w1, true);
                    if (hh == 0) { xw[0] = (unsigned)w0; xw[1] = (unsigned)w1; } else { yw[0] = (unsigned)w0; yw[1] = (unsigned)w1; } }
                auto r0 = __builtin_amdgcn_permlane16_swap(xw[0], yw[0], false, false); auto r1 = __builtin_amdgcn_permlane16_swap(xw[1], yw[1], false, false);
                const unsigned a0 = r0[0], b0 = r0[1], a1 = r1[0], b1 = r1[1];
                *(u32x4*)(he + (size_t)(ai * 128 + mp * 32) * DE) = (u32x4){a0, a1, b0, b1}; }
    }
};
struct EpiDown {
    static constexpr bool PERM = true; static constexpr bool F8 = true; static constexpr bool I8 = false;
    unsigned char* ws; LAS const int* tb;
    __device__ __forceinline__ void operator()(const Acc& acc, const pg8::Unit& u, int wr, int wc, int fr, int fq) const {
        unsigned char* y = ws + WS_X + X_YT + ((size_t)u.pm * 256 + wr * 64 + fr + (fq & 1) * 16) * DM + u.pn * 256 + wc * 32 + 8 * (fq & 2);
#pragma unroll
        for (int ai = 0; ai < 2; ++ai) RAG_IF(ai)
#pragma unroll
            for (int mp = 0; mp < 2; ++mp)
#pragma unroll
                for (int bj = 0; bj < 2; ++bj) {
                    unsigned xw[2], yw[2];
#pragma unroll
                    for (int h = 0; h < 2; ++h) { const f32x4 v0 = acc[ai][bj][2 * mp + h][0] * (1.0f / F8_WD), v1 = acc[ai][bj][2 * mp + h][1] * (1.0f / F8_WD);
                        int w0 = __builtin_amdgcn_cvt_pk_fp8_f32(v0[0], v0[1], 0, false); w0 = __builtin_amdgcn_cvt_pk_fp8_f32(v0[2], v0[3], w0, true);
                        int w1 = __builtin_amdgcn_cvt_pk_fp8_f32(v1[0], v1[1], 0, false); w1 = __builtin_amdgcn_cvt_pk_fp8_f32(v1[2], v1[3], w1, true);
                        if (h == 0) { xw[0] = (unsigned)w0; xw[1] = (unsigned)w1; } else { yw[0] = (unsigned)w0; yw[1] = (unsigned)w1; } }
                    auto r0 = __builtin_amdgcn_permlane16_swap(xw[0], yw[0], false, false); auto r1 = __builtin_amdgcn_permlane16_swap(xw[1], yw[1], false, false);
                    const unsigned a0 = r0[0], b0 = r0[1], a1 = r1[0], b1 = r1[1];
                    *(u32x4*)(y + (size_t)(ai * 128 + mp * 32) * DM + bj * 128) = (u32x4){a0, a1, b0, b1}; }
    }
};
constexpr int WR3_BYTES = 32 * 9 * 64 * 16;
__device__ __forceinline__ void route_tile(LAS unsigned char* lds, unsigned char* ws, const float* H, unsigned* cnt, int layer, int row0, int wave, int lane, bool dry) {
    LAS unsigned* lcnt = (LAS unsigned*)(lds + 65536); LAS unsigned* lbase = lcnt + 32;
    if (wave == 0 && lane < 32) lcnt[lane] = 0u;
    asm volatile("s_waitcnt lgkmcnt(0)" ::: "memory"); __syncthreads();
    int e1 = 0, e2 = 0; unsigned p1 = 0u, p2 = 0u; float g1 = 0.f, g2 = 0.f;
    const bool act = row0 >= 0;
    const int r = lane & 15, g = lane >> 4;
    float rs = 0.f;
    LAS float* L = (LAS float*)(lds + (wave & 3) * 8192);
    if (act) {
        const u32x4* ap0 = (const u32x4*)(WSA(bf16_t, WS_HB) + (size_t)(row0 + r) * DM) + g; const u32x4* ap1 = ap0 + 16 * (DM / 8);
        const u32x4* bp = (const u32x4*)(ws + WS_WR + (size_t)layer * WR3_BYTES) + lane;
        f32x4 acc[2][3]; float ss0 = 0.f, ss1 = 0.f;
#pragma unroll
        for (int h = 0; h < 2; ++h)
#pragma unroll
            for (int cb = 0; cb < 3; ++cb) acc[h][cb] = (f32x4){0.f, 0.f, 0.f, 0.f};
        u32x4 a0n = ap0[0], a1n = ap1[0], bn[9];
#pragma unroll
        for (int f = 0; f < 9; ++f) bn[f] = bp[f * 64];
#pragma unroll 1
        for (int j = 0; j < 32; ++j) {
            const u32x4 a0 = a0n, a1 = a1n; u32x4 b[9];
#pragma unroll
            for (int f = 0; f < 9; ++f) b[f] = bn[f];
            if (j + 1 < 32) { a0n = ap0[4 * (j + 1)]; a1n = ap1[4 * (j + 1)];
#pragma unroll
                for (int f = 0; f < 9; ++f) bn[f] = bp[((j + 1) * 9 + f) * 64]; }
#pragma unroll
            for (int q = 0; q < 4; ++q) { const float x0 = bf2f(a0[q] & 0xffffu), x1 = bf2f(a0[q] >> 16), y0 = bf2f(a1[q] & 0xffffu), y1 = bf2f(a1[q] >> 16); ss0 += x0 * x0 + x1 * x1; ss1 += y0 * y0 + y1 * y1; }
#pragma unroll
            for (int t = 0; t < 3; ++t)
#pragma unroll
                for (int cb = 0; cb < 3; ++cb) {
                    acc[0][cb] = __builtin_amdgcn_mfma_f32_16x16x32_bf16(__builtin_bit_cast(bf16x8, a0), __builtin_bit_cast(bf16x8, b[t * 3 + cb]), acc[0][cb], 0, 0, 0);
                    acc[1][cb] = __builtin_amdgcn_mfma_f32_16x16x32_bf16(__builtin_bit_cast(bf16x8, a1), __builtin_bit_cast(bf16x8, b[t * 3 + cb]), acc[1][cb], 0, 0, 0); }
        }
        ss0 = xadd16(ss0); ss0 = xadd32(ss0); ss1 = xadd16(ss1); ss1 = xadd32(ss1);
        rs = 1.0f / sqrtf((g == 0 ? ss0 : ss1) * (1.0f / DM) + EPS);
#pragma unroll
        for (int h = 0; h < 2; ++h)
#pragma unroll
            for (int cb = 0; cb < 3; ++cb)
#pragma unroll
                for (int q = 0; q < 4; ++q) L[(16 * h + 4 * g + q) * 48 + cb * 16 + r] = acc[h][cb][q];
    }
    asm volatile("s_waitcnt lgkmcnt(0)" ::: "memory");
    if (act && lane < 32) {
        const int row = row0 + lane;
        float lg[40];
#pragma unroll
        for (int q = 0; q < 10; ++q) { const f32x4 v = *(LAS const f32x4*)(L + lane * 48 + 4 * q); lg[4 * q] = v[0] * rs; lg[4 * q + 1] = v[1] * rs; lg[4 * q + 2] = v[2] * rs; lg[4 * q + 3] = v[3] * rs; }
        (dry ? WSA(float, WS_AO + 8 * MiB) : WSA(float, WS_SMALL + SM_RSTD2))[row] = rs;
        int gid = 0; float gm = lg[0];
#pragma unroll
        for (int c = 1; c < 8; ++c) if (lg[c] > gm) { gm = lg[c]; gid = c; }
        float den = 0.f;
#pragma unroll
        for (int c = 0; c < 8; ++c) den += expf(lg[c] - gm);
        const float gw = 1.0f / den;
        float e4[4];
#pragma unroll
        for (int c = 0; c < 4; ++c) { float v = lg[8 + c];
#pragma unroll
            for (int gg = 1; gg < 8; ++gg) v = (gid == gg) ? lg[8 + gg * 4 + c] : v;
            e4[c] = v; }
        int i1 = 0; float v1 = e4[0];
#pragma unroll
        for (int c = 1; c < 4; ++c) if (e4[c] > v1) { v1 = e4[c]; i1 = c; }
        int i2 = -1; float v2 = -INFINITY;
#pragma unroll
        for (int c = 0; c < 4; ++c) if (c != i1 && e4[c] > v2) { v2 = e4[c]; i2 = c; }
        const float ex = expf(v2 - v1); g1 = gw / (1.0f + ex); g2 = gw * ex / (1.0f + ex);
        e1 = gid * 4 + i1; e2 = gid * 4 + i2;
        p1 = __hip_atomic_fetch_add(lcnt + e1, 1u, __ATOMIC_RELAXED, __HIP_MEMORY_SCOPE_WORKGROUP); p2 = __hip_atomic_fetch_add(lcnt + e2, 1u, __ATOMIC_RELAXED, __HIP_MEMORY_SCOPE_WORKGROUP);
    }
    asm volatile("s_waitcnt lgkmcnt(0)" ::: "memory"); __syncthreads();
    if (wave == 0 && lane < 32) lbase[lane] = atomicAdd(cnt + lane * 64, lcnt[lane]);
    asm volatile("s_waitcnt vmcnt(0) lgkmcnt(0)" ::: "memory"); __syncthreads();
    if (act && lane < 32) {
        const int row = row0 + lane;
        unsigned* list = dry ? WSA(unsigned, WS_AO) : WSA(unsigned, WS_SMALL + SM_LIST);
        const unsigned q1 = lbase[e1] + p1, q2 = lbase[e2] + p2;
        list[(size_t)e1 * T + q1] = (unsigned)row * 2u; list[(size_t)e2 * T + q2] = (unsigned)row * 2u + 1u;
        if (!dry) { unsigned* tsl = WSA(unsigned, WS_SMALL + SM_TSLOT) + (size_t)row * 2; tsl[0] = (q1 << 5) | (unsigned)e1; tsl[1] = (q2 << 5) | (unsigned)e2; }
        float* gt = dry ? WSA(float, WS_AO + 9 * MiB) : WSA(float, WS_SMALL + SM_GATE); gt[row * 2] = g1; gt[row * 2 + 1] = g2;
    }
    asm volatile("s_waitcnt lgkmcnt(0)" ::: "memory");
}
__device__ __forceinline__ void combine_row(unsigned char* ws, float* out, const float* final_norm, int last, int row, int lane, bool dry, LAS const int* tb) {
    const unsigned long long* hb = (const unsigned long long*)(WSA(bf16_t, WS_HB) + (size_t)row * DM) + lane;
    const unsigned t0 = WSA(unsigned, WS_SMALL + SM_TSLOT)[(size_t)row * 2], t1 = WSA(unsigned, WS_SMALL + SM_TSLOT)[(size_t)row * 2 + 1];
    const float g0 = WSA(float, WS_SMALL + SM_GATE)[row * 2], g1 = WSA(float, WS_SMALL + SM_GATE)[row * 2 + 1];
    const size_t a0 = (size_t)tb[t0 & 31u] * 256 + (t0 >> 5), a1 = (size_t)tb[t1 & 31u] * 256 + (t1 >> 5);
    const unsigned* y0 = (const unsigned*)(ws + WS_X + X_YT + a0 * DM) + lane; const unsigned* y1 = (const unsigned*)(ws + WS_X + X_YT + a1 * DM) + lane;
    f32x4 v[4]; float s = 0.f;
#pragma unroll
    for (int j = 0; j < 4; ++j) { const unsigned long long c = hb[64 * j]; const int a = (int)y0[64 * j], b = (int)y1[64 * j];
        v[j].x = bf2f((unsigned)c & 0xffffu) + (g0 * __builtin_amdgcn_cvt_f32_fp8(a, 0) + g1 * __builtin_amdgcn_cvt_f32_fp8(b, 0));
        v[j].y = bf2f(((unsigned)c) >> 16) + (g0 * __builtin_amdgcn_cvt_f32_fp8(a, 1) + g1 * __builtin_amdgcn_cvt_f32_fp8(b, 1));
        v[j].z = bf2f((unsigned)(c >> 32) & 0xffffu) + (g0 * __builtin_amdgcn_cvt_f32_fp8(a, 2) + g1 * __builtin_amdgcn_cvt_f32_fp8(b, 2));
        v[j].w = bf2f((unsigned)(c >> 48)) + (g0 * __builtin_amdgcn_cvt_f32_fp8(a, 3) + g1 * __builtin_amdgcn_cvt_f32_fp8(b, 3));
        s += v[j].x * v[j].x + v[j].y * v[j].y + v[j].z * v[j].z + v[j].w * v[j].w; }
    s = wave_sum(s);
    const float rs = 1.0f / sqrtf(s * (1.0f / DM) + EPS);
    if (last) {
        const f32x4* g = (const f32x4*)final_norm + lane; f32x4* ho = (f32x4*)((dry ? WSA(float, WS_Z + 64 * MiB) : out) + (size_t)row * DM) + lane;
#pragma unroll
        for (int j = 0; j < 4; ++j) { const f32x4 gg = g[64 * j]; ho[64 * j] = (f32x4){v[j].x * rs * gg.x, v[j].y * rs * gg.y, v[j].z * rs * gg.z, v[j].w * rs * gg.w}; }
    } else {
        unsigned long long* o8 = (unsigned long long*)((dry ? WSA(bf16_t, WS_AO) : WSA(bf16_t, WS_HB)) + (size_t)row * DM) + lane;
#pragma unroll
        for (int j = 0; j < 4; ++j) o8[64 * j] = (unsigned long long)pk2(v[j].x, v[j].y) | ((unsigned long long)pk2(v[j].z, v[j].w) << 32);
        float mx = 0.f;
#pragma unroll
        for (int j = 0; j < 4; ++j) mx = fmaxf(fmaxf(mx, fmaxf(fabsf(v[j].x), fabsf(v[j].y))), fmaxf(fabsf(v[j].z), fabsf(v[j].w)));
        mx = wave_max0(mx); const float inv = mx > 0.f ? 127.0f / mx : 0.f;
        if (!dry) { unsigned* a8 = (unsigned*)(ws + WS_Z + Z_A8 + (size_t)row * DM) + lane;
#pragma unroll
            for (int j = 0; j < 4; ++j) a8[64 * j] = q4_i8(v[j].x, v[j].y, v[j].z, v[j].w, inv); }
        if (lane == 0 && !dry) WSA(float, WS_SMALL + SM_RSTD)[row] = rs * (mx * (1.0f / 127.0f));
    }
}

constexpr int AT_NSLOT = 3, AT_KBUF = 0, AT_KSTRIDE = 12288, AT_VBUF = AT_NSLOT * 12288, AT_VSTRIDE = 8192, AT_WSF = AT_VBUF + AT_NSLOT * 8192, AT_OST = AT_WSF + 2048;
static_assert(AT_OST + 65536 <= RING_BYTES, "attention LDS map");
constexpr float AT_THR = 8.0f;
__device__ __forceinline__ int crow(int r, int hi) { return (r & 3) + 8 * (r >> 2) + 4 * hi; }
typedef short s16x4 __attribute__((ext_vector_type(4)));
__device__ __forceinline__ s16x4 vtr(LAS const unsigned char* p) { return __builtin_bit_cast(s16x4, __builtin_amdgcn_ds_read_tr16_b64_v4i16((LAS s16x4*)p)); }
__device__ __forceinline__ unsigned cvtpk(float lo, float hi) { typedef float f2 __attribute__((ext_vector_type(2))); typedef __bf16 b2 __attribute__((ext_vector_type(2))); f2 v = {lo, hi}; b2 b = __builtin_convertvector(v, b2); return __builtin_bit_cast(unsigned, b); }
__device__ __forceinline__ unsigned cvtpk_v(float lo, float hi) { unsigned r; asm volatile("v_cvt_pk_bf16_f32 %0, %1, %2" : "=v"(r) : "v"(lo), "v"(hi)); return r; }
__device__ __forceinline__ float xmax32(float v) { const unsigned a = __builtin_bit_cast(unsigned, v); auto r = __builtin_amdgcn_permlane32_swap(a, a, false, false); const unsigned x = r[0], y = r[1]; return fmaxf(__builtin_bit_cast(float, x), __builtin_bit_cast(float, y)); }

__device__ __forceinline__ void glds16(const void* gsrc, unsigned lds_dst) { unsigned keep;
    asm volatile("s_mov_b32 %0, m0\n\ts_mov_b32 m0, %2\n\ts_nop 0\n\tglobal_load_lds_dwordx4 %1, off\n\ts_mov_b32 m0, %0" : "=&s"(keep) : "v"(gsrc), "s"(lds_dst) : "memory"); }
__device__ __forceinline__ int attn_prefetch(LAS unsigned char* lds, unsigned char* ws, const unsigned un, const int vslot, const int wave, const int lane, bf16x8 (&qn)[6]) {
    const bool nfox = (un & 1u) != 0u; const int qb = 15 - (int)(un >> 7), bh = (int)(un & 127u) >> 1, b = bh >> 3, h = bh & 7;
    const size_t row0 = (size_t)b * SEQ;
    int t0 = 0;
    if (nfox && qb > 0) {
        const float* km2 = WSA(float, WS_SMALL + SM_D + 20480) + (size_t)b * 16 * 8 + h; float kk = 0.f;
        for (int j = 0; j < 16; ++j) kk = fmaxf(kk, km2[j * 8]);
        const float qq = WSA(float, WS_SMALL + SM_D + 16384)[((size_t)b * 16 + qb) * 8 + h];
        const float bound = 2.05f * sqrtf(qq * kk) + 32.0f;
        const float* dt = WSA(float, WS_SMALL + SM_D + 32768) + ((size_t)b * 8 + h) * 64; const float dref = dt[4 * qb - 1];
        const bool far = (lane < 4 * qb) && (dref - dt[lane] <= -bound);
        t0 = __popcll(__ballot(far));
    }
    const bf16_t* Km_ = (nfox ? WSA(bf16_t, WS_X + X_FK) : WSA(bf16_t, WS_Z + Z_KM)) + h * 64;
    const bf16_t* Vm_ = (nfox ? WSA(bf16_t, WS_X + X_FV) : WSA(bf16_t, WS_Z + Z_VM)) + h * 64;
    const int krow = wave * 8 + (lane >> 3), kch = (lane & 7) ^ ((krow >> 1) & 7);
    const bf16_t* ksrc0 = Km_ + (row0 + krow) * 512 + kch * 8 + (size_t)t0 * 64 * 512;
    const int xrow = wave * 16 + (lane >> 2);
    const bf16_t* ksrc1 = nfox ? WSA(bf16_t, WS_X + X_KA) + (((size_t)b * 8 + h) * SEQ + lane) * 8 + (size_t)t0 * 64 * 8
                               : WSA(bf16_t, WS_Z + Z_KR) + (row0 + xrow) * ROPE + ((lane & 3) ^ ((xrow >> 2) & 3)) * 8 + (size_t)t0 * 64 * ROPE;
    const size_t katile = nfox ? (size_t)64 * 8 : (size_t)64 * ROPE;
    const bool k1 = nfox ? (wave == 0) : (wave < 4);
    const bf16_t* vsrc = Vm_ + (row0 + 16 * (wave & 3) + (lane >> 2)) * 512 + (wave >> 2) * 32 + (lane & 3) * 8 + (size_t)t0 * 64 * 512;
    const unsigned lds0 = (unsigned)(unsigned long)lds;
    glds16(ksrc0, (unsigned)__builtin_amdgcn_readfirstlane(lds0 + AT_KBUF + wave * 1024));
    if (k1) glds16(ksrc1, (unsigned)__builtin_amdgcn_readfirstlane(lds0 + AT_KBUF + 8192 + wave * 1024));
    glds16(ksrc0 + (size_t)64 * 512, (unsigned)__builtin_amdgcn_readfirstlane(lds0 + AT_KBUF + AT_KSTRIDE + wave * 1024));
    if (k1) glds16(ksrc1 + katile, (unsigned)__builtin_amdgcn_readfirstlane(lds0 + AT_KBUF + AT_KSTRIDE + 8192 + wave * 1024));
    glds16(vsrc, (unsigned)__builtin_amdgcn_readfirstlane(lds0 + AT_VBUF + vslot * AT_VSTRIDE + wave * 1024));
    { const int r32 = lane & 31, hi = lane >> 5; const size_t qr_ = row0 + (size_t)qb * 256 + wave * 32 + r32;
      const bf16_t* qrow = nfox ? WSA(bf16_t, WS_X + X_FQ) + h * 64 + qr_ * FW + hi * 8 : WSA(bf16_t, WS_Z + Z_QM) + h * MDK + qr_ * (MH * MDK) + hi * 8;
      const bf16_t* q4 = nfox ? WSA(bf16_t, WS_X + X_QA) + h * 8 + qr_ * 64 : qrow + 64;
      const bf16_t* q5 = nfox ? q4 : qrow + 80;
#pragma unroll
      for (int d0 = 0; d0 < 4; ++d0) qn[d0] = *(const bf16x8*)(qrow + d0 * 16);
      qn[4] = *(const bf16x8*)q4; qn[5] = *(const bf16x8*)q5; }
    return t0;
}
template <bool FOX, int ABL>
__device__ __forceinline__ void attn_unit(LAS unsigned char* lds, unsigned char* ws, const int b, const int h, const int qb, const int wave_in, int lane, const bool dry,
                                          const bool pre, const int t0p, const int vs0, const unsigned raw, volatile LAS unsigned* qword, unsigned& unext, int& t0n, int& vsn, bf16x8 (&qx)[6]) {
    asm volatile("" : "+v"(lane));
    int wave = wave_in; asm volatile("" : "+s"(wave));
    constexpr int DKS = FOX ? 5 : 6;
    const int r32 = lane & 31, hi = lane >> 5;
    const size_t row0 = (size_t)b * SEQ; const int q0 = qb * 256;
    const bf16_t* Qm_; const bf16_t* Km_; int qkp; constexpr int kp = 512;
    if (FOX) { Qm_ = WSA(bf16_t, WS_X + X_FQ) + h * 64; Km_ = WSA(bf16_t, WS_X + X_FK) + h * 64; qkp = FW; }
    else { Qm_ = WSA(bf16_t, WS_Z + Z_QM) + h * MDK; Km_ = WSA(bf16_t, WS_Z + Z_KM) + h * 64; qkp = MH * MDK; }
    const bf16_t* Vm_ = FOX ? WSA(bf16_t, WS_X + X_FV) + h * 64 : WSA(bf16_t, WS_Z + Z_VM) + h * 64;
    const bf16_t* QA = WSA(bf16_t, WS_X + X_QA) + h * 8;
    const int krow = wave * 8 + (lane >> 3), kch = (lane & 7) ^ ((krow >> 1) & 7);
    const bf16_t* ksrc0 = Km_ + (row0 + krow) * kp + kch * 8;
    const int xrow = FOX ? lane : (wave * 16 + (lane >> 2));
    const bf16_t* ksrc1 = FOX ? WSA(bf16_t, WS_X + X_KA) + (((size_t)b * 8 + h) * SEQ + lane) * 8 : WSA(bf16_t, WS_Z + Z_KR) + (row0 + xrow) * ROPE + ((lane & 3) ^ ((xrow >> 2) & 3)) * 8;
    const bool k1 = FOX ? (wave == 0) : (wave < 4);
    const bf16_t* vsrc = Vm_ + (row0 + 16 * (wave & 3) + (lane >> 2)) * 512 + (wave >> 2) * 32 + (lane & 3) * 8;
    const size_t ktile = (size_t)64 * kp, katile = FOX ? (size_t)64 * 8 : (size_t)64 * ROPE, vtile = (size_t)64 * 512;
    const unsigned lds0 = (unsigned)(unsigned long)lds;
#define AT_RFL(x) ((unsigned)__builtin_amdgcn_readfirstlane(x))
#define AT_DMAK(t, slot) do { glds16(ksrc0 + (size_t)(t) * ktile, AT_RFL(lds0 + AT_KBUF + (slot) * AT_KSTRIDE + wave * 1024)); \
        if (k1) glds16(ksrc1 + (size_t)(t) * katile, AT_RFL(lds0 + AT_KBUF + (slot) * AT_KSTRIDE + 8192 + wave * 1024)); } while (0)
#define AT_DMAV(t, slot) glds16(vsrc + (size_t)(t) * vtile, AT_RFL(lds0 + AT_VBUF + (slot) * AT_VSTRIDE + wave * 1024))
    int t0 = t0p;
    if (!pre) {
      if (FOX && qb > 0) {
        const float* km2 = WSA(float, WS_SMALL + SM_D + 20480) + (size_t)b * 16 * 8 + h; float kk = 0.f;
        for (int j = 0; j < 16; ++j) kk = fmaxf(kk, km2[j * 8]);
        const float qq = WSA(float, WS_SMALL + SM_D + 16384)[((size_t)b * 16 + qb) * 8 + h];
        const float bound = 2.05f * sqrtf(qq * kk) + 32.0f;
        const float* dt = WSA(float, WS_SMALL + SM_D + 32768) + ((size_t)b * 8 + h) * 64; const float dref = dt[4 * qb - 1];
        const bool far = (lane < 4 * qb) && (dref - dt[lane] <= -bound);
        t0 = __popcll(__ballot(far));
      }
      asm volatile("s_waitcnt lgkmcnt(0)" ::: "memory"); __builtin_amdgcn_s_barrier(); asm volatile("" ::: "memory");
    }
    if (!pre) { AT_DMAK(t0, 0); AT_DMAK(t0 + 1, 1); AT_DMAV(t0, vs0); }
    bf16x8 qr[DKS];
    if (pre) {
#pragma unroll
      for (int d0 = 0; d0 < DKS; ++d0) qr[d0] = qx[d0];
    } else { const bf16_t* qrow = Qm_ + (row0 + q0 + wave * 32 + r32) * qkp + hi * 8;
#pragma unroll
      for (int d0 = 0; d0 < (FOX ? 4 : 6); ++d0) qr[d0] = *(const bf16x8*)(qrow + d0 * 16);
      if (FOX) qr[DKS - 1] = *(const bf16x8*)(QA + (row0 + q0 + wave * 32 + r32) * 64); }
    if (FOX) { if (hi) qr[DKS - 1] = (bf16x8){0, 0, 0, 0, 0, 0, 0, 0}; }
    LAS float* wsf = (LAS float*)(lds + AT_WSF) + wave * 64;
    float mhat = 0.f, l_reg = 0.f; f32x16 o0 = {}, o1 = {}, negm = {};
    const int NT = (q0 + 256) / 64, qrel = wave * 32 + r32;
    const int ksw = (r32 >> 1) & 7, ksx = (r32 >> 2) & 3;
    const int voff = ((lane >> 4) & 1) * 32 + (lane & 3) * 8 + (4 * hi + ((lane & 15) >> 2)) * 64;
#define SBAR() __builtin_amdgcn_sched_barrier(0)
#define AT_KRDH(D0, F, H) do { \
        if ((D0) < 4) { const int o_ = r32 * 128 + (((2 * (D0) + hi) ^ ksw) << 4); F = *(LAS const bf16x8*)(kb + o_ + (H) * 4096); } \
        else if (FOX) { const int o_ = 8192 + r32 * 16; F = *(LAS const bf16x8*)(kb + o_ + (H) * 512); } \
        else { const int o_ = 8192 + r32 * 64 + (((2 * ((D0) - 4) + hi) ^ ksx) << 4); F = *(LAS const bf16x8*)(kb + o_ + (H) * 2048); } } while (0)
#define AT_KRD(D0, F0, F1) do { \
        if ((D0) < 4) { const int o_ = r32 * 128 + (((2 * (D0) + hi) ^ ksw) << 4); F0 = *(LAS const bf16x8*)(kb + o_); F1 = *(LAS const bf16x8*)(kb + o_ + 4096); } \
        else if (FOX) { const int o_ = 8192 + r32 * 16; F0 = *(LAS const bf16x8*)(kb + o_); F1 = *(LAS const bf16x8*)(kb + o_ + 512); } \
        else { const int o_ = 8192 + r32 * 64 + (((2 * ((D0) - 4) + hi) ^ ksx) << 4); F0 = *(LAS const bf16x8*)(kb + o_); F1 = *(LAS const bf16x8*)(kb + o_ + 2048); } } while (0)
#define AT_VRD(i) do { vlo[i] = vtr(vb + ((i) >> 2) * 4096 + ((i) & 3) * 1024); vhi[i] = vtr(vb + ((i) >> 2) * 4096 + ((i) & 3) * 1024 + 512); } while (0)
#define AT_VFR(i) (bf16x8){vlo[i][0], vlo[i][1], vlo[i][2], vlo[i][3], vhi[i][0], vhi[i][1], vhi[i][2], vhi[i][3]}
#define AT_PIN(x) asm volatile("" : "+v"(x))
#define AT_ROWMAX(C0, C1, RM) do { float a = fmaxf(fmaxf(C0[0], C0[1]), C1[0]), bb = fmaxf(fmaxf(C0[2], C0[3]), C1[1]); a = fmaxf(fmaxf(a, C1[2]), C1[3]); \
        _Pragma("unroll") for (int r = 4; r < 16; r += 4) { a = fmaxf(fmaxf(a, C0[r]), C0[r + 1]); bb = fmaxf(fmaxf(bb, C0[r + 2]), C0[r + 3]); a = fmaxf(fmaxf(a, C1[r]), C1[r + 1]); bb = fmaxf(fmaxf(bb, C1[r + 2]), C1[r + 3]); } \
        RM = xmax32(fmaxf(a, bb)); } while (0)
#define AT_MASK(C0, C1, T) do { const int jb = (T) - (NT - 4); if (jb >= 0) { const int kb0 = 64 * jb + 4 * hi; \
        _Pragma("unroll") for (int r = 0; r < 16; ++r) { const int kv = kb0 + (r & 3) + 8 * (r >> 2); if (kv > qrel) C0[r] = -INFINITY; if (kv + 32 > qrel) C1[r] = -INFINITY; } } } while (0)
#define AT_GAPA(I, P0, P1) do { \
        if ((I) < 4) { sacc += P0[4 * (I)]; sacc += P0[4 * (I) + 1]; sacc += P0[4 * (I) + 2]; sacc += P0[4 * (I) + 3]; } \
        else { sacc += P1[4 * ((I) - 4)]; sacc += P1[4 * ((I) - 4) + 1]; sacc += P1[4 * ((I) - 4) + 2]; sacc += P1[4 * ((I) - 4) + 3]; } \
        AT_PIN(sacc); \
        if ((I) == 0) { pw0[0] = cvtpk_v(P0[0], P0[1]); pw0[1] = cvtpk_v(P0[2], P0[3]); AT_PIN(pw0); } \
        if ((I) == 1) { pw0[2] = cvtpk_v(P0[4], P0[5]); pw0[3] = cvtpk_v(P0[6], P0[7]); AT_PIN(pw0); } \
        if ((I) == 2) { pw1[0] = cvtpk_v(P0[8], P0[9]); pw1[1] = cvtpk_v(P0[10], P0[11]); AT_PIN(pw1); } \
        if ((I) == 3) { pw1[2] = cvtpk_v(P0[12], P0[13]); pw1[3] = cvtpk_v(P0[14], P0[15]); AT_PIN(pw1); } \
        if ((I) == 4) { pw2[0] = cvtpk_v(P1[0], P1[1]); pw2[1] = cvtpk_v(P1[2], P1[3]); AT_PIN(pw2); } \
        if ((I) == 5) { pw2[2] = cvtpk_v(P1[4], P1[5]); pw2[3] = cvtpk_v(P1[6], P1[7]); AT_PIN(pw2); } \
        if ((I) == 6) { pw3[0] = cvtpk_v(P1[8], P1[9]); pw3[1] = cvtpk_v(P1[10], P1[11]); AT_PIN(pw3); } \
        if ((I) == 7) { pw3[2] = cvtpk_v(P1[12], P1[13]); pw3[3] = cvtpk_v(P1[14], P1[15]); AT_PIN(pw3); } } while (0)
#define AT_STEP(C0, C1, P0, P1, T, KS, VS, KS2, VS2) do { \
        LAS const unsigned char* kb = lds + AT_KBUF + (KS) * AT_KSTRIDE; LAS const unsigned char* vb = lds + AT_VBUF + (VS) * AT_VSTRIDE + voff; \
        bf16x8 kfa0, kfa1, kfb0, kfb1; s16x4 vlo[8], vhi[8]; u32x4 pw0, pw1, pw2, pw3; float sacc = 0.f; \
        SBAR(); AT_KRD(0, kfa0, kfa1); SBAR(); \
          \
        _Pragma("unroll") for (int d0 = 0; d0 < DKS; ++d0) { \
            if (d0 + 1 < DKS) { if (d0 & 1) AT_KRDH(d0 + 1, kfa0, 0); else AT_KRDH(d0 + 1, kfb0, 0); } \
            if (2 * d0 < 8) AT_VRD(2 * d0 < 8 ? (((2 * d0) & 1) * 4 + ((2 * d0) >> 1)) : 0); \
            SBAR(); \
            C0 = __builtin_amdgcn_mfma_f32_32x32x16_bf16((d0 & 1) ? kfb0 : kfa0, qr[d0], d0 == 0 ? negm : C0, 0, 0, 0); \
            if (2 * d0 < 8) AT_GAPA(2 * d0 < 8 ? 2 * d0 : 0, P0, P1); \
            SBAR(); \
            if (d0 + 1 < DKS) { if (d0 & 1) AT_KRDH(d0 + 1, kfa1, 1); else AT_KRDH(d0 + 1, kfb1, 1); } \
            if (2 * d0 + 1 < 8) AT_VRD(2 * d0 + 1 < 8 ? (((2 * d0 + 1) & 1) * 4 + ((2 * d0 + 1) >> 1)) : 0); \
            SBAR(); \
            C1 = __builtin_amdgcn_mfma_f32_32x32x16_bf16((d0 & 1) ? kfb1 : kfa1, qr[d0], d0 == 0 ? negm : C1, 0, 0, 0); \
            if (2 * d0 + 1 < 8) AT_GAPA(2 * d0 + 1 < 8 ? 2 * d0 + 1 : 0, P0, P1); \
            SBAR(); } \
        l_reg += sacc; \
        if ((T) + 2 < NT) AT_DMAK((T) + 2, KS2); \
        if ((T) + 1 < NT) AT_DMAV((T) + 1, VS2); \
        AT_MASK(C0, C1, T); \
        float rm; AT_ROWMAX(C0, C1, rm); \
        bool resc = false; \
        if (__builtin_expect(__any(rm > AT_THR), 0)) { const float dl = fmaxf(rm, 0.f); mhat += dl; \
            _Pragma("unroll") for (int r = 0; r < 16; ++r) { C0[r] -= dl; C1[r] -= dl; negm[r] = -mhat; } \
            const float f = __builtin_amdgcn_exp2f(-dl); l_reg *= f; { int ro_ = r32; asm volatile("" : "+v"(ro_)); if (hi == 0) wsf[ro_] = f; } resc = true; } \
        SBAR(); \
          \
        AT_GAPB(o0, pw0, 0, C0, 0); AT_GAPB(o1, pw0, 4, C0, 4); AT_GAPB(o0, pw1, 1, C0, 8); AT_GAPB(o1, pw1, 5, C0, 12); \
        AT_GAPB(o0, pw2, 2, C1, 0); AT_GAPB(o1, pw2, 6, C1, 4); AT_GAPB(o0, pw3, 3, C1, 8); AT_GAPB(o1, pw3, 7, C1, 12); \
        if (resc) { asm volatile("s_waitcnt lgkmcnt(0)" ::: "memory"); \
            _Pragma("unroll") for (int r = 0; r < 16; ++r) { const float fr_ = wsf[crow(r, hi)]; o0[r] *= fr_; o1[r] *= fr_; } } \
    } while (0)
#define AT_GAPB(ODST, PW, VI, X, B) do { ODST = __builtin_amdgcn_mfma_f32_32x32x16_bf16(__builtin_bit_cast(bf16x8, PW), AT_VFR(VI), ODST, 0, 0, 0); \
        X[B] = __builtin_amdgcn_exp2f(X[B]); X[(B) + 1] = __builtin_amdgcn_exp2f(X[(B) + 1]); X[(B) + 2] = __builtin_amdgcn_exp2f(X[(B) + 2]); X[(B) + 3] = __builtin_amdgcn_exp2f(X[(B) + 3]); AT_PIN(X); SBAR(); } while (0)
#define AT_ENDSTEP(T) do { if ((T) + 2 < NT) { if (k1) asm volatile("s_waitcnt vmcnt(3) lgkmcnt(0)" ::: "memory"); else asm volatile("s_waitcnt vmcnt(2) lgkmcnt(0)" ::: "memory"); } \
        else asm volatile("s_waitcnt vmcnt(0) lgkmcnt(0)" ::: "memory"); \
        __builtin_amdgcn_s_barrier(); asm volatile("" ::: "memory"); } while (0)
    f32x16 pa0, pa1, pb0, pb1;
    if (pre) asm volatile("s_waitcnt vmcnt(4)" ::: "memory");
    else if (k1) asm volatile("s_waitcnt vmcnt(3)" ::: "memory"); else asm volatile("s_waitcnt vmcnt(2)" ::: "memory");
    __builtin_amdgcn_s_barrier(); asm volatile("" ::: "memory");
    AT_DMAK(t0 + 2, 2); AT_DMAV(t0 + 1, (vs0 == 2 ? 0 : vs0 + 1));
    { LAS const unsigned char* kb = lds + AT_KBUF;
#pragma unroll
      for (int d0 = 0; d0 < DKS; ++d0) { bf16x8 f0, f1; AT_KRD(d0, f0, f1);
          pa0 = __builtin_amdgcn_mfma_f32_32x32x16_bf16(f0, qr[d0], d0 == 0 ? negm : pa0, 0, 0, 0); pa1 = __builtin_amdgcn_mfma_f32_32x32x16_bf16(f1, qr[d0], d0 == 0 ? negm : pa1, 0, 0, 0); }
      AT_MASK(pa0, pa1, t0);
      float rm; AT_ROWMAX(pa0, pa1, rm); mhat = rm;
#pragma unroll
      for (int r = 0; r < 16; ++r) { pa0[r] = __builtin_amdgcn_exp2f(pa0[r] - rm); pa1[r] = __builtin_amdgcn_exp2f(pa1[r] - rm); negm[r] = -mhat; } }
    if (t0 + 2 < NT) { if (k1) asm volatile("s_waitcnt vmcnt(3) lgkmcnt(0)" ::: "memory"); else asm volatile("s_waitcnt vmcnt(2) lgkmcnt(0)" ::: "memory"); }
    else asm volatile("s_waitcnt vmcnt(0) lgkmcnt(0)" ::: "memory");
    if (wave == 0 && lane == 0) { unsigned rw = raw; asm volatile("" : "+v"(rw)); qword[0] = rw; }
    __builtin_amdgcn_s_barrier(); asm volatile("" ::: "memory");
    int t = t0 + 1;
    int ks = 1, vs = vs0;
#define AT_NEXT3(x) ((x) == 2 ? 0 : (x) + 1)
#define AT_PREV3(x) ((x) == 0 ? 2 : (x) - 1)
    if ((NT - t) & 1) {
        AT_STEP(pb0, pb1, pa0, pa1, t, ks, vs, AT_PREV3(ks), AT_NEXT3(AT_NEXT3(vs))); AT_ENDSTEP(t);
        pa0 = pb0; pa1 = pb1; ++t; ks = AT_NEXT3(ks); vs = AT_NEXT3(vs);
    }
#pragma unroll 1
    for (; t < NT; t += 2) {
        AT_STEP(pb0, pb1, pa0, pa1, t, ks, vs, AT_PREV3(ks), AT_NEXT3(AT_NEXT3(vs))); AT_ENDSTEP(t);
        ks = AT_NEXT3(ks); vs = AT_NEXT3(vs);
        AT_STEP(pa0, pa1, pb0, pb1, t + 1, ks, vs, AT_PREV3(ks), AT_NEXT3(AT_NEXT3(vs))); AT_ENDSTEP(t + 1);
        ks = AT_NEXT3(ks); vs = AT_NEXT3(vs);
    }
    unext = qword[0]; vsn = (vs == 2 ? 0 : vs + 1); t0n = 0;
    if (unext < 2048u) t0n = attn_prefetch(lds, ws, unext, vsn, wave, lane, qx);
    else {
#pragma unroll
        for (int d0 = 0; d0 < 6; ++d0) qx[d0] = qr[d0 < DKS ? d0 : 0]; }
    { float sacc = 0.f;
#pragma unroll
      for (int r = 0; r < 16; ++r) sacc += pa0[r] + pa1[r];
      l_reg += sacc;
      const u32x4 pw0 = {cvtpk(pa0[0], pa0[1]), cvtpk(pa0[2], pa0[3]), cvtpk(pa0[4], pa0[5]), cvtpk(pa0[6], pa0[7])}, pw1 = {cvtpk(pa0[8], pa0[9]), cvtpk(pa0[10], pa0[11]), cvtpk(pa0[12], pa0[13]), cvtpk(pa0[14], pa0[15])};
      const u32x4 pw2 = {cvtpk(pa1[0], pa1[1]), cvtpk(pa1[2], pa1[3]), cvtpk(pa1[4], pa1[5]), cvtpk(pa1[6], pa1[7])}, pw3 = {cvtpk(pa1[8], pa1[9]), cvtpk(pa1[10], pa1[11]), cvtpk(pa1[12], pa1[13]), cvtpk(pa1[14], pa1[15])};
      LAS const unsigned char* vb = lds + AT_VBUF + vs * AT_VSTRIDE + voff; s16x4 vlo[8], vhi[8];
#pragma unroll
      for (int i = 0; i < 8; ++i) AT_VRD(i);
      o0 = __builtin_amdgcn_mfma_f32_32x32x16_bf16(__builtin_bit_cast(bf16x8, pw0), AT_VFR(0), o0, 0, 0, 0); o1 = __builtin_amdgcn_mfma_f32_32x32x16_bf16(__builtin_bit_cast(bf16x8, pw0), AT_VFR(4), o1, 0, 0, 0);
      o0 = __builtin_amdgcn_mfma_f32_32x32x16_bf16(__builtin_bit_cast(bf16x8, pw1), AT_VFR(1), o0, 0, 0, 0); o1 = __builtin_amdgcn_mfma_f32_32x32x16_bf16(__builtin_bit_cast(bf16x8, pw1), AT_VFR(5), o1, 0, 0, 0);
      o0 = __builtin_amdgcn_mfma_f32_32x32x16_bf16(__builtin_bit_cast(bf16x8, pw2), AT_VFR(2), o0, 0, 0, 0); o1 = __builtin_amdgcn_mfma_f32_32x32x16_bf16(__builtin_bit_cast(bf16x8, pw2), AT_VFR(6), o1, 0, 0, 0);
      o0 = __builtin_amdgcn_mfma_f32_32x32x16_bf16(__builtin_bit_cast(bf16x8, pw3), AT_VFR(3), o0, 0, 0, 0); o1 = __builtin_amdgcn_mfma_f32_32x32x16_bf16(__builtin_bit_cast(bf16x8, pw3), AT_VFR(7), o1, 0, 0, 0); }
#undef AT_STEP
#undef AT_GAPA
#undef AT_GAPB
#undef AT_ENDSTEP
#undef AT_KRD
#undef AT_KRDH
#undef AT_VRD
#undef AT_VFR
#undef AT_PIN
#undef AT_ROWMAX
#undef AT_MASK
#undef AT_NEXT3
#undef AT_PREV3
#undef SBAR
#undef AT_DMAK
#undef AT_DMAV
#undef AT_RFL
    l_reg = xadd32(l_reg);
    if (hi == 0) wsf[32 + r32] = l_reg;
    asm volatile("s_waitcnt lgkmcnt(0)" ::: "memory");
    LAS float* stg = (LAS float*)(lds + AT_OST) + wave * 2048;
#pragma unroll
    for (int r = 0; r < 16; ++r) { const int orow = crow(r, hi); const float il = __builtin_amdgcn_rcpf(wsf[32 + orow]);
        stg[orow * 64 + r32] = o0[r] * il; stg[orow * 64 + 32 + r32] = o1[r] * il; }
    asm volatile("s_waitcnt lgkmcnt(0)" ::: "memory");
    unsigned char* ao = ws + (dry ? WS_HB : WS_AO) + (row0 + q0 + wave * 32) * DM + (FOX ? 0 : FW) + h * 64;
#pragma unroll
    for (int i = 0; i < 4; ++i) { const int row = i * 8 + (lane >> 3), ch = lane & 7;
        const f32x4 a = *(LAS const f32x4*)(stg + row * 64 + ch * 8), bq = *(LAS const f32x4*)(stg + row * 64 + ch * 8 + 4);
        float ss = sq8(a, bq); ss += dppf<0xB1>(ss); ss += dppf<0x4E>(ss); ss += dppf<0x141>(ss);
        const float rs = 1.0f / sqrtf(ss * (1.0f / 64.0f) + EPS);
        const float qs = rs * (127.0f / AO_C);
        *(u32x2*)(ao + (size_t)row * DM + ch * 8) = (u32x2){q4_i8c(a[0], a[1], a[2], a[3], qs), q4_i8c(bq[0], bq[1], bq[2], bq[3], qs)}; }
    asm volatile("" : "+v"(qx[0]), "+v"(qx[1]), "+v"(qx[2]), "+v"(qx[3]), "+v"(qx[4]), "+v"(qx[5]));
}
constexpr int CW_ATTQ = 15360;
template <int ABL>
__device__ __forceinline__ void attn_phase(LAS unsigned char* lds, unsigned char* ws, unsigned* qhead, int wave, int lane, bool dry) {
    volatile LAS unsigned* qw = (volatile LAS unsigned*)(lds + MISC_OFF + 64);
    const bool leader = (wave == 0 && lane == 0);
    if (leader) qw[0] = atomicAdd(qhead, 1u);
    asm volatile("s_waitcnt vmcnt(0) lgkmcnt(0)" ::: "memory"); __syncthreads();
    unsigned u = qw[0];
    bool pre = false; int t0p = 0, vs0 = 0, par = 0; bf16x8 qx[6];
#pragma unroll 1
    while (u < 2048u) {
        unsigned raw;
        if (leader) { const unsigned one = 1u; asm volatile("global_atomic_add %0, %1, %2, off sc0" : "=v"(raw) : "v"(qhead), "v"(one) : "memory"); }
        const int qb = 15 - (int)(u >> 7), bh = (int)(u & 127u) >> 1, b = bh >> 3, h = bh & 7;
        unsigned un = 2048u; int t0n = 0, vsn = 0;
        if (u & 1u) attn_unit<true, ABL>(lds, ws, b, h, qb, wave, lane, dry, pre, t0p, vs0, raw, qw + 1 + par, un, t0n, vsn, qx);
        else attn_unit<false, ABL>(lds, ws, b, h, qb, wave, lane, dry, pre, t0p, vs0, raw, qw + 1 + par, un, t0n, vsn, qx);
        u = un; pre = true; t0p = t0n; vs0 = vsn; par ^= 1;
    }
    asm volatile("s_waitcnt vmcnt(0) lgkmcnt(0)" ::: "memory"); __syncthreads();
}

#define XB_TMO      128
#define XB_XCNT(j)  (256  + 64 * (j))
#define XB_XSUB(j)  (1280 + 64 * (j))
#define XB_XGEN(j)  (2304 + 64 * (j))
#define XB_TOP      3328
#define XB_TOPGEN   3392
#define XCD_BAR_WORDS 3456
#define XB_SPIN_CAP (1u << 18)
constexpr int CW_BAR = 4096;
__device__ __forceinline__ unsigned xb_ld(unsigned* p)              { return __hip_atomic_load(p, __ATOMIC_RELAXED, __HIP_MEMORY_SCOPE_AGENT); }
__device__ __forceinline__ unsigned xb_add(unsigned* p, unsigned v) { return __hip_atomic_fetch_add(p, v, __ATOMIC_RELAXED, __HIP_MEMORY_SCOPE_AGENT); }
__device__ __forceinline__ unsigned xb_xcc_id() { return (unsigned)__builtin_amdgcn_s_getreg((3 << 11) | 20) & 0xFu; }
#define XB_SPIN(cond, bar) do { unsigned _sp = 0; while (cond) { __builtin_amdgcn_s_sleep(1); \
    if ((++_sp & 255u) == 0u) { if (xb_ld(&(bar)[XB_TMO])) break; if (_sp > XB_SPIN_CAP) { atomicAdd(&(bar)[XB_TMO], 1u); break; } } } } while (0)
struct XcdBarrier { unsigned* bar; unsigned x; volatile LAS unsigned* st; };
__device__ __forceinline__ XcdBarrier xcd_barrier_post(unsigned* bar, volatile LAS unsigned* st) {
    XcdBarrier b; b.bar = bar; b.x = xb_xcc_id(); b.st = st;
    if (threadIdx.x == 0) (void)xb_add(&bar[XB_XCNT(b.x)], 1u);
    return b;
}
__device__ __forceinline__ void xcd_barrier_complete(unsigned* bar, unsigned x, unsigned& nloc, unsigned& nx) {
    const unsigned G = gridDim.x * gridDim.y * gridDim.z;
    unsigned sum, cnt, mine, sp = 0u;
    for (;;) {
        sum = 0u; cnt = 0u; mine = 0u;
#pragma unroll
        for (unsigned j = 0; j < 16; ++j) { const unsigned c = xb_ld(&bar[XB_XCNT(j)]); sum += c; cnt += (c > 0u) ? 1u : 0u; mine = (j == x) ? c : mine; }
        if (sum == G) break;
        __builtin_amdgcn_s_sleep(1);
        if ((++sp & 255u) == 0u) { if (xb_ld(&bar[XB_TMO])) break; if (sp > XB_SPIN_CAP) { atomicAdd(&bar[XB_TMO], 1u); break; } }
    }
    nloc = mine > 0u ? mine : 1u; nx = cnt > 0u ? cnt : 1u;
}
__device__ __forceinline__ void xcd_barrier(const XcdBarrier& b) {
    asm volatile("s_waitcnt vmcnt(0)" ::: "memory");
    __syncthreads();
    if (threadIdx.x == 0) {
        unsigned* bar = b.bar;
        __builtin_amdgcn_s_waitcnt(0);
        unsigned nloc = b.st[0], nx = b.st[1];
        if (nloc == 0u) { xcd_barrier_complete(bar, b.x, nloc, nx); b.st[0] = nloc; b.st[1] = nx; }
        const unsigned old = xb_add(&bar[XB_XSUB(b.x)], 1u);
        const unsigned gen = old / nloc;
        if (old + 1u == (gen + 1u) * nloc) {
            __builtin_amdgcn_fence(__ATOMIC_RELEASE, "agent");
            asm volatile("s_waitcnt vmcnt(0)" ::: "memory");
            const unsigned og = xb_add(&bar[XB_TOP], 1u);
            const unsigned tg = og / nx;
            if (og + 1u == (tg + 1u) * nx) xb_add(&bar[XB_TOPGEN], 1u);
            else XB_SPIN(xb_ld(&bar[XB_TOPGEN]) == tg, bar);
            __builtin_amdgcn_fence(__ATOMIC_ACQUIRE, "agent");
            xb_add(&bar[XB_XGEN(b.x)], 1u);
            asm volatile("s_waitcnt vmcnt(0)" ::: "memory");
        } else {
            XB_SPIN(xb_ld(&bar[XB_XGEN(b.x)]) == gen, bar);
            __builtin_amdgcn_fence(__ATOMIC_ACQUIRE, "agent");
            asm volatile("s_waitcnt vmcnt(0)" ::: "memory");
        }
    }
    __syncthreads();
}

__device__ __forceinline__ void scan_tile(unsigned char* ws, int bt, int lane) {
    asm volatile("" : "+v"(lane));
    const int tile = bt & 15; const size_t r0 = (size_t)bt * 256 + (size_t)lane * 4;
    const float* ts = WSA(float, WS_SMALL + SM_D) + (size_t)(bt - tile) * 16;
    f32x4 base0 = {0.f, 0.f, 0.f, 0.f}, base1 = base0;
    for (int j = 0; j < tile; ++j) { const f32x4* p = (const f32x4*)(ts + j * 16); base0 += p[0] + p[2]; base1 += p[1] + p[3]; }
    const f32x4* lf = (const f32x4*)(WSA(float, WS_SMALL + SM_LF) + r0 * 8);
    f32x4 v[4][2];
#pragma unroll
    for (int i = 0; i < 4; ++i) { v[i][0] = lf[2 * i]; v[i][1] = lf[2 * i + 1]; }
#pragma unroll
    for (int i = 1; i < 4; ++i) { v[i][0] += v[i - 1][0]; v[i][1] += v[i - 1][1]; }
    f32x4 p0 = v[3][0], p1 = v[3][1];
#pragma unroll
    for (int o = 1; o < 64; o <<= 1) {
#pragma unroll
        for (int j = 0; j < 4; ++j) { const float x0 = p0[j], x1 = p1[j];
            const int y0 = __builtin_amdgcn_ds_bpermute((lane - o) << 2, __builtin_bit_cast(int, x0)), y1 = __builtin_amdgcn_ds_bpermute((lane - o) << 2, __builtin_bit_cast(int, x1));
            if (lane >= o) { p0[j] = x0 + __builtin_bit_cast(float, y0); p1[j] = x1 + __builtin_bit_cast(float, y1); } } }
    const f32x4 e0 = base0 + (p0 - v[3][0]), e1 = base1 + (p1 - v[3][1]);
    if (lane < 16) { const int h = lane & 7, which = lane >> 3;
        const f32x4 t4 = *(const f32x4*)(WSA(float, WS_SMALL + SM_D + 65536) + (((size_t)which * 128 + bt) * 8 + h) * 4);
        WSA(float, WS_SMALL + SM_D + (which ? 20480 : 16384))[bt * 8 + h] = fmaxf(t4[0], t4[1]) + fmaxf(t4[2], t4[3]); }
    bf16_t* qa = WSA(bf16_t, WS_X + X_QA) + r0 * 64; bf16_t* ka = WSA(bf16_t, WS_X + X_KA) + ((size_t)(bt >> 4) * 8 * SEQ + (size_t)(bt & 15) * 256 + (size_t)lane * 4) * 8;
    unsigned one = 0x3f80u; asm volatile("" : "+v"(one));
#pragma unroll
    for (int i = 0; i < 4; ++i)
#pragma unroll
        for (int h = 0; h < 8; ++h) { const float D = ((h < 4) ? (e0[h & 3] + v[i][0][h & 3]) : (e1[h & 3] + v[i][1][h & 3])) * LOG2E;
            const unsigned d1 = f2bf(D); const float r1 = D - bf2f(d1); const unsigned d2 = f2bf(r1); const float r2 = r1 - bf2f(d2); const unsigned d3 = f2bf(r2);
            *(u32x4*)(qa + i * 64 + h * 8) = (u32x4){one | (one << 16), one | (d1 << 16), d2 | (d3 << 16), 0u};
            *(u32x4*)(ka + ((size_t)h * SEQ + i) * 8) = (u32x4){(d1 ^ 0x8000u) | ((d2 ^ 0x8000u) << 16), (d3 ^ 0x8000u) | (one << 16), one | (one << 16), 0u};
            if (i == 3 && (lane & 15) == 15) WSA(float, WS_SMALL + SM_D + 32768)[((size_t)(bt >> 4) * 8 + h) * 64 + (bt & 15) * 4 + (lane >> 4)] = D; }
}

__device__ __forceinline__ void pro_item(const float* __restrict__ src, const float* __restrict__ src2, const float* __restrict__ gain, const float* __restrict__ gain2, bf16_t* __restrict__ dst,
                                         const int K, const int Nsrc, const int Ndst, const int mode, LAS float* scr, const int item, const int lane, const float f8s = 0.f) {
    const int nblk = Ndst / 32, kb = item / nblk, nb = item % nblk, k0 = 64 * kb, n0 = 32 * nb;
    const int kr = lane >> 3, n = n0 + 4 * (lane & 7); int col; const float* sp = src;
    if (mode == 0) col = map_in(n); else if (mode == 1) col = map_uq(n); else if (mode == 2) col = map_ukv(n); else if (mode == 3) col = n;
    else { const int pn = n >> 8, w = n & 255; if (w < 128) col = pn * 128 + w; else { col = pn * 128 + (w - 128); sp = src2; } }
    f32x4 vals[8];
#pragma unroll
    for (int i = 0; i < 8; ++i) { const int k = k0 + 8 * i + kr; vals[i] = col >= 0 ? *(const f32x4*)(sp + (size_t)k * Nsrc + col) : (f32x4){0.f, 0.f, 0.f, 0.f}; }
#pragma unroll
    for (int i = 0; i < 8; ++i) { const int kk = 8 * i + kr, k = k0 + kk;
        float g = 1.f; if (gain) g = (gain2 && k >= 512) ? gain2[k - 512] : gain[k];
        LAS float* sw = scr + kk * 33 + 4 * (lane & 7); sw[0] = vals[i][0] * g; sw[1] = vals[i][1] * g; sw[2] = vals[i][2] * g; sw[3] = vals[i][3] * g; }
    asm volatile("s_waitcnt lgkmcnt(0)" ::: "memory");
    const int c = lane & 7;
#pragma unroll
    for (int j = 0; j < 4; ++j) { const int nn = (lane >> 3) + 8 * j; const LAS float* sq = scr + (8 * c) * 33 + nn;
        if (f8s != 0.f) {
            int w0 = __builtin_amdgcn_cvt_pk_fp8_f32(sq[0 * 33] * f8s, sq[1 * 33] * f8s, 0, false); w0 = __builtin_amdgcn_cvt_pk_fp8_f32(sq[2 * 33] * f8s, sq[3 * 33] * f8s, w0, true);
            int w1 = __builtin_amdgcn_cvt_pk_fp8_f32(sq[4 * 33] * f8s, sq[5 * 33] * f8s, 0, false); w1 = __builtin_amdgcn_cvt_pk_fp8_f32(sq[6 * 33] * f8s, sq[7 * 33] * f8s, w1, true);
            *(u32x2*)((unsigned char*)dst + (size_t)(n0 + nn) * K + k0 + 8 * c) = (u32x2){(unsigned)w0, (unsigned)w1};
        } else {
        u32x4 o; o.x = pk2(sq[0 * 33], sq[1 * 33]); o.y = pk2(sq[2 * 33], sq[3 * 33]); o.z = pk2(sq[4 * 33], sq[5 * 33]); o.w = pk2(sq[6 * 33], sq[7 * 33]);
        *(u32x4*)(dst + (size_t)(n0 + nn) * K + k0 + 8 * c) = o; } }
    asm volatile("s_waitcnt lgkmcnt(0)" ::: "memory");
}
template <bool WO>
__device__ __forceinline__ void pro_win_i8(LAS unsigned char* lds, const float* __restrict__ src, const float* __restrict__ gain, const float* __restrict__ gain2, unsigned char* __restrict__ dst8, float* __restrict__ wcs, const int nb, const int wave, const int lane) {
    LAS float* scr = (LAS float*)(lds + wave * 16384); LAS float* red = (LAS float*)(lds + 8448);
    const int n0 = 32 * nb, n = n0 + (lane & 31), col = WO ? n : map_in(n), kh = lane >> 5; constexpr int NS = WO ? DM : IN_W;
    const float* gv = (WO && wave >= 4) ? gain2 - 512 : gain;
    float va[32], vb[32]; float mx = 0.f;
#pragma unroll
    for (int i = 0; i < 32; ++i) { const int k = 128 * wave + 2 * i + kh; va[i] = col >= 0 ? src[(size_t)k * NS + col] * gv[k] : 0.f; vb[i] = col >= 0 ? src[(size_t)(k + 64) * NS + col] * gv[k + 64] : 0.f; }
#pragma unroll
    for (int i = 0; i < 32; ++i) mx = fmaxf(mx, fmaxf(fabsf(va[i]), fabsf(vb[i])));
    mx = xmx32(mx);
    if (lane < 32) red[wave * 32 + lane] = mx;
    asm volatile("s_waitcnt lgkmcnt(0)" ::: "memory"); __syncthreads();
#pragma unroll
    for (int w = 0; w < 8; ++w) mx = fmaxf(mx, red[w * 32 + (lane & 31)]);
    const float inv = mx > 0.f ? 127.0f / mx : 0.f;
    if (wave == 0 && lane < 32) wcs[n] = mx * (1.0f / 127.0f);
#pragma unroll
    for (int h = 0; h < 2; ++h) {
#pragma unroll
        for (int i = 0; i < 32; ++i) scr[(2 * i + kh) * 33 + (lane & 31)] = __builtin_rintf((h ? vb[i] : va[i]) * inv);
        asm volatile("s_waitcnt lgkmcnt(0)" ::: "memory");
        const int c = lane & 7;
#pragma unroll
        for (int j = 0; j < 4; ++j) { const int nn = (lane >> 3) + 8 * j; const LAS float* sq = scr + (8 * c) * 33 + nn;
            const unsigned w0 = q4_i8(sq[0 * 33], sq[1 * 33], sq[2 * 33], sq[3 * 33], 1.0f), w1 = q4_i8(sq[4 * 33], sq[5 * 33], sq[6 * 33], sq[7 * 33], 1.0f);
            *(u32x2*)(dst8 + (size_t)(n0 + nn) * DM + 128 * wave + 64 * h + 8 * c) = (u32x2){w0, w1}; }
        asm volatile("s_waitcnt lgkmcnt(0)" ::: "memory");
    }
    __syncthreads();
}
__device__ __forceinline__ void prologue_phase(LAS unsigned char* lds, unsigned char* ws, const MkArgs& args, int vcu, int G, int wave, int lane) {
    LAS float* scr = (LAS float*)(lds + wave * 16384);
    const int gw = vcu * NWAVES + wave, NGW = G * NWAVES;
    constexpr int I_IN = 16 * 64, I_UQ = 4 * 24, I_UKV = 2 * 32, I_WO = 16 * 32, I_GU = 16 * 16, I_D = 4 * 32, I_L = I_IN + I_UQ + I_UKV + I_WO + NE * (I_GU + I_D);
    const float* attn_norm = args.in[2]; const float* w_in = args.in[3]; const float* q_norm = args.in[5]; const float* w_uq = args.in[6]; const float* kv_norm = args.in[7]; const float* w_ukv = args.in[8];
    const float* fox_on = args.in[9]; const float* mla_on = args.in[10]; const float* w_o = args.in[11]; const float* ffn_norm = args.in[12]; const float* w_group = args.in[13]; const float* w_router = args.in[14];
    const float* w_gate = args.in[15]; const float* w_up = args.in[16]; const float* w_down = args.in[17];
    if (vcu < DEPTH * (IN_WP / 32)) { const int l = vcu / (IN_WP / 32), nb = vcu % (IN_WP / 32);
        pro_win_i8<false>(lds, w_in + (size_t)l * DM * IN_W, attn_norm + l * DM, nullptr, ws + WS_WIN + (size_t)l * IN_WP * DM, WSA(float, WS_SMALL + SM_WCS) + l * IN_WP, nb, wave, lane); }
    else if (vcu < DEPTH * (IN_WP / 32) + DEPTH * (DM / 32)) { const int j = vcu - DEPTH * (IN_WP / 32), l = j / (DM / 32), nb = j % (DM / 32);
        pro_win_i8<true>(lds, w_o + (size_t)l * DM * DM, fox_on + l * FW, mla_on + l * MW, ws + WS_WO + (size_t)l * DM * DM, WSA(float, WS_SMALL + SM_WCS2) + l * DM, nb, wave, lane); }
#pragma unroll 1
    for (int it = gw; it < DEPTH * I_L; it += NGW) {
        const int l = it / I_L; int r = it % I_L;
        if (r < I_IN) continue; r -= I_IN;
        if (r < I_UQ) { pro_item(w_uq + (size_t)l * QL * 768, nullptr, q_norm + l * QL, nullptr, WSA(bf16_t, WS_WUQ) + (size_t)l * 768 * QL, QL, 768, 768, 1, scr, r, lane); continue; } r -= I_UQ;
        if (r < I_UKV) { pro_item(w_ukv + (size_t)l * KVL * 1024, nullptr, kv_norm + l * KVL, nullptr, WSA(bf16_t, WS_WUKV) + (size_t)l * 1024 * KVL, KVL, 1024, 1024, 2, scr, r, lane); continue; } r -= I_UKV;
        if (r < I_WO) continue; r -= I_WO;
        if (r < NE * I_GU) { const size_t le = (size_t)l * NE + r / I_GU;
            pro_item(w_gate + le * DM * DE, w_up + le * DM * DE, ffn_norm + l * DM, nullptr, (bf16_t*)(ws + WS_WGU + le * 512 * DM), DM, DE, 512, 4, scr, r % I_GU, lane, F8_WGU); continue; } r -= NE * I_GU;
        { const size_t le = (size_t)l * NE + r / I_D;
          pro_item(w_down + le * DE * DM, nullptr, nullptr, nullptr, (bf16_t*)(ws + WS_WD + le * DM * DE), DE, DM, DM, 3, scr, r % I_D, lane, F8_WD); }
    }
    const int gt = gw * 64 + lane, NGT = NGW * 64;
    for (int i = gt; i < DEPTH * (WR3_BYTES / 2); i += NGT) {
        const int l = i / (WR3_BYTES / 2), x = i % (WR3_BYTES / 2), e = x & 7, ln = (x >> 3) & 63, f = x >> 9, cb = f % 3, t = (f / 3) % 3, j = f / 9;
        const int k = 32 * j + 8 * (ln >> 4) + e, c = 16 * cb + (ln & 15);
        float v = 0.f; if (c < 8) v = w_group[((size_t)l * DM + k) * NG + c]; else if (c < 40) v = w_router[((size_t)l * DM + k) * NE + (c - 8)];
        v *= ffn_norm[l * DM + k];
        const float hi = bf2f(f2bf(v)), r1 = v - hi, mid = bf2f(f2bf(r1)), lo = r1 - mid;
        ((bf16_t*)(ws + WS_WR))[i] = (bf16_t)f2bf(t == 0 ? hi : (t == 1 ? mid : lo)); }
    for (int i = gt; i < T * 16; i += NGT) { const int t = i >> 4, j = i & 15;
        const float inv = powf(10000.0f, -(float)j / 16.0f); const float ang = (float)args.pos[t] * inv;
        WSA(float2, WS_ROPE)[i] = make_float2(cosf(ang), sinf(ang)); }
    for (int row = 2 * gw; row < T; row += 2 * NGW) {
        const f32x4* xr = (const f32x4*)(args.x + (size_t)row * DM) + lane;
        float s0 = 0.f, s1 = 0.f; f32x4 v[8];
#pragma unroll
        for (int j = 0; j < 8; ++j) v[j] = xr[64 * j];
#pragma unroll
        for (int j = 0; j < 4; ++j) { s0 += v[j].x * v[j].x + v[j].y * v[j].y + v[j].z * v[j].z + v[j].w * v[j].w; s1 += v[4 + j].x * v[4 + j].x + v[4 + j].y * v[4 + j].y + v[4 + j].z * v[4 + j].z + v[4 + j].w * v[4 + j].w; }
        s0 = wave_sum(s0); s1 = wave_sum(s1);
        float m0 = 0.f, m1 = 0.f;
#pragma unroll
        for (int j = 0; j < 4; ++j) { m0 = fmaxf(fmaxf(m0, fmaxf(fabsf(v[j].x), fabsf(v[j].y))), fmaxf(fabsf(v[j].z), fabsf(v[j].w))); m1 = fmaxf(fmaxf(m1, fmaxf(fabsf(v[4 + j].x), fabsf(v[4 + j].y))), fmaxf(fabsf(v[4 + j].z), fabsf(v[4 + j].w))); }
        m0 = wave_max0(m0); m1 = wave_max0(m1);
        const float i0 = m0 > 0.f ? 127.0f / m0 : 0.f, i1 = m1 > 0.f ? 127.0f / m1 : 0.f;
        { unsigned* a8 = (unsigned*)(ws + WS_Z + Z_A8 + (size_t)row * DM) + lane;
#pragma unroll
          for (int j = 0; j < 8; ++j) a8[64 * j] = q4_i8(v[j].x, v[j].y, v[j].z, v[j].w, j < 4 ? i0 : i1); }
        if (lane == 0) { WSA(float, WS_SMALL + SM_RSTD)[row] = m0 * (1.0f / 127.0f) / sqrtf(s0 * (1.0f / DM) + EPS); WSA(float, WS_SMALL + SM_RSTD)[row + 1] = m1 * (1.0f / 127.0f) / sqrtf(s1 * (1.0f / DM) + EPS); }
    }
}

constexpr int PROBE_ABL = 0;
constexpr int PROBE_PH = -1;
constexpr int PH_PRO = 0, PH_PER_LAYER = 8, PH_TOTAL = 1 + PH_PER_LAYER * DEPTH;
enum { PL_INPROJ = 0, PL_UP = 1, PL_ATTN = 2, PL_WO = 3, PL_ROUTE = 4, PL_GU = 5, PL_DOWN = 6, PL_COMB = 7 };

__global__ void __launch_bounds__(NWAVES * 64, 2) mk_fwd(MkArgs args) {
    extern __shared__ __attribute__((aligned(16))) unsigned char lds_raw[];
    LAS unsigned char* lds = (LAS unsigned char*)lds_raw;
    volatile LAS unsigned* MISC = (volatile LAS unsigned*)(lds + MISC_OFF);
    const int tid = threadIdx.x; const int wave_k = __builtin_amdgcn_readfirstlane(tid >> 6);
    const int G = gridDim.x; const int bx = blockIdx.x;
    unsigned char* const ws_k = args.ws;
    unsigned* ctl = (unsigned*)(ws_k + WS_CTL);
    for (int u = tid; u < (LDS_BYTES - RING_BYTES) / 4; u += NWAVES * 64) ((LAS unsigned*)(lds + RING_BYTES))[u] = 0u;
    __syncthreads();
    const int lo = args.ph_lo, hi = args.ph_hi;
    const bool multi = (hi - lo) > 1;
    XcdBarrier bar; bar.bar = ctl + CW_BAR; bar.x = 0; bar.st = nullptr;
    if (multi) bar = xcd_barrier_post(ctl + CW_BAR, MISC + 8);
#define PHASE_LOCALS int lane; asm volatile("v_mbcnt_lo_u32_b32 %0, -1, 0\n\tv_mbcnt_hi_u32_b32 %0, -1, %0" : "=v"(lane)); size_t zoff = 0; asm volatile("" : "+s"(zoff)); unsigned char* const ws = ws_k + zoff; int bxo = blockIdx.x; asm volatile("" : "+s"(bxo)); const int vcu = (G % 8 == 0) ? (bxo % 8) * (G / 8) + bxo / 8 : bxo
#define IN(k) (pk == (k))
#define SEAM(k) do { } while (0)
    bool probed = false;
#pragma unroll 1
    for (int ph = lo; ph < hi; ++ph) {
        if (ph == PH_PRO) { { PHASE_LOCALS; const int wave = wave_k; prologue_phase(lds, ws, args, vcu, G, wave, lane); } if (ph + 1 < hi) xcd_barrier(bar); if (PROBE_PH == 0 && !probed) { probed = true; --ph; } continue; }
        const int wave = wave_k; const bool dry = (PROBE_PH > 0 && ph == PROBE_PH && !probed);
        int l = (ph - 1) / PH_PER_LAYER; const int pk = (ph - 1) % PH_PER_LAYER; asm volatile("" : "+s"(l)); const int pb = 0;
#ifndef DBG_MASK
#define DBG_MASK 0xff
#endif
        if (((DBG_MASK >> PL_INPROJ) & 1) && IN(pb + PL_INPROJ)) {
            PHASE_LOCALS;
            pg8::DenseOrder S; S.init(ws + WS_Z + Z_A8, ws + WS_WIN + (size_t)l * IN_WP * DM, T, IN_WP, DM / 2, G, bxo); S.rot = (G == 256) ? 2 : 0;
            EpiInProj E{ws, args.b_f + l * FH, WSA(float, WS_SMALL + SM_WCS) + l * IN_WP};
            pg8::gemm_phase<EpiInProj, pg8::DenseOrder>(lds, wave, DM / 2, S, E, (dry && PROBE_ABL < 3) ? PROBE_ABL : 0);
        }
        SEAM(pb + PL_INPROJ);
        if (((DBG_MASK >> PL_UP) & 1) && IN(pb + PL_UP)) {
            PHASE_LOCALS;
            { const int sblk = (G >= 144) ? bxo - 128 : vcu; const int gw = sblk * NWAVES + wave; if (sblk >= 0 && gw < BATCH * 16) scan_tile(ws, gw, lane); }
#ifndef NO_Q
            { pg8::DenseOrder S; S.init(ws + WS_X + X_CQ, WSA(bf16_t, WS_WUQ) + (size_t)l * 768 * QL, T, 768, QL, G, bxo);
              EpiUpQ E{ws}; pg8::gemm_phase<EpiUpQ, pg8::DenseOrder>(lds, wave, QL, S, E); }
#endif
#ifndef NO_KV
            { pg8::DenseOrder S; S.init(ws + WS_X + X_CKV, WSA(bf16_t, WS_WUKV) + (size_t)l * 1024 * KVL, T, 1024, KVL, G, bxo);
              EpiUpKV E{ws}; pg8::gemm_phase<EpiUpKV, pg8::DenseOrder>(lds, wave, KVL, S, E); }
#endif
        }
        SEAM(pb + PL_UP);
        if (((DBG_MASK >> PL_ATTN) & 1) && IN(pb + PL_ATTN)) {
            PHASE_LOCALS;
            unsigned* qhead = ctl + CW_ATTQ + 64 * (dry ? 2 : l);
            if (PROBE_ABL != 0 && dry) attn_phase<PROBE_ABL>(lds, ws, qhead, wave, lane, true); else attn_phase<0>(lds, ws, qhead, wave, lane, dry);
        }
        SEAM(pb + PL_ATTN);
        if (((DBG_MASK >> PL_WO) & 1) && IN(pb + PL_WO)) {
            PHASE_LOCALS;
            pg8::DenseOrder S; S.init(ws + WS_AO, ws + WS_WO + (size_t)l * DM * DM, T, DM, DM / 2, G, bxo);
            EpiWo E{ws, l == 0 ? args.x : nullptr, WSA(float, WS_SMALL + SM_WCS2) + l * DM};
            pg8::gemm_phase<EpiWo, pg8::DenseOrder>(lds, wave, DM / 2, S, E);
        }
        SEAM(pb + PL_WO);
        if (((DBG_MASK >> PL_ROUTE) & 1) && IN(pb + PL_ROUTE)) {
            PHASE_LOCALS;
            for (int rb = vcu; rb < T / 128; rb += G)
                route_tile(lds, ws, args.H, ctl + CW_CNT + 2048 * (dry ? 2 : l), l, wave < 4 ? rb * 128 + wave * 32 : -1, wave, lane, dry);
        }
        SEAM(pb + PL_ROUTE);
        if (((DBG_MASK >> PL_GU) & 1) && IN(pb + PL_GU)) {
            PHASE_LOCALS;
            moe_build_tb(lds, ctl + CW_CNT + 2048 * l, wave, lane);
            MoeOrder<2, true> S; S.tb = (LAS const int*)(lds + TB_OFF); S.A = (const char*)(ws + WS_X + X_H8); S.Bt = (const char*)(ws + WS_WGU + (size_t)l * NE * 512 * DM);
            S.list = WSA(unsigned, WS_SMALL + SM_LIST); S.K = DM / 2; S.G = G; S.c = bxo; S.bstride = (size_t)512 * DM;
            EpiGU E{ws, (LAS const int*)(lds + TB_OFF)};
            pg8::gemm_phase<EpiGU, MoeOrder<2, true>>(lds, wave, DM / 2, S, E);
        }
        SEAM(pb + PL_GU);
        if (((DBG_MASK >> PL_DOWN) & 1) && IN(pb + PL_DOWN)) {
            PHASE_LOCALS;
            moe_build_tb(lds, ctl + CW_CNT + 2048 * l, wave, lane);
            MoeOrder<4, false> S; S.tb = (LAS const int*)(lds + TB_OFF); S.A = (const char*)(ws + WS_Z + Z_HE); S.Bt = (const char*)(ws + WS_WD + (size_t)l * NE * DM * DE);
            S.list = nullptr; S.K = DE / 2; S.G = G; S.c = bxo; S.bstride = (size_t)DM * DE;
            EpiDown E{ws, (LAS const int*)(lds + TB_OFF)};
            pg8::gemm_phase<EpiDown, MoeOrder<4, false>>(lds, wave, DE / 2, S, E);
        }
        SEAM(pb + PL_DOWN);
        if (((DBG_MASK >> PL_COMB) & 1) && IN(pb + PL_COMB)) {
            PHASE_LOCALS;
            moe_build_tb(lds, ctl + CW_CNT + 2048 * l, wave, lane);
            for (int row = vcu * NWAVES + wave; row < T; row += G * NWAVES) combine_row(ws, args.H, args.final_norm, l == DEPTH - 1, row, lane, dry, (LAS const int*)(lds + TB_OFF));
        }
        SEAM(pb + PL_COMB);
        if (ph + 1 < hi) xcd_barrier(bar);
        if (PROBE_PH > 0 && ph == PROBE_PH && !probed) { probed = true; --ph; }
    }
#undef IN
#undef SEAM
}
static int g_grid = 0;
static void launch_mk(MkArgs a, int lo, int hi, hipStream_t s) { a.ph_lo = lo; a.ph_hi = hi; hipLaunchKernelGGL(mk_fwd, dim3(g_grid), dim3(NWAVES * 64), LDS_BYTES, s, a); }
extern "C" void kernel_launch(void* const* d_in, const int* in_sizes, int n_in, void* d_out, int out_size, void* d_ws, size_t ws_size, hipStream_t stream) {
    if (n_in != 19 || out_size != T * DM || ws_size < WS_END) { fprintf(stderr, "kernel_launch: unexpected shapes (n_in %d out %d ws %zu)\n", n_in, out_size, ws_size); return; }
    const float* x = (const float*)d_in[0]; const int* pos = (const int*)d_in[1];
    const float* attn_norm = (const float*)d_in[2]; const float* w_in = (const float*)d_in[3]; const float* b_f = (const float*)d_in[4];
    const float* q_norm = (const float*)d_in[5]; const float* w_uq = (const float*)d_in[6]; const float* kv_norm = (const float*)d_in[7]; const float* w_ukv = (const float*)d_in[8];
    const float* fox_on = (const float*)d_in[9]; const float* mla_on = (const float*)d_in[10]; const float* w_o = (const float*)d_in[11];
    const float* ffn_norm = (const float*)d_in[12]; const float* w_group = (const float*)d_in[13]; const float* w_router = (const float*)d_in[14];
    const float* w_gate = (const float*)d_in[15]; const float* w_up = (const float*)d_in[16]; const float* w_down = (const float*)d_in[17]; const float* final_norm = (const float*)d_in[18];
    unsigned char* ws = (unsigned char*)d_ws;
    if (g_grid == 0) {
        int dev = 0, cus = 0;
        if (hipGetDevice(&dev) != hipSuccess || hipDeviceGetAttribute(&cus, hipDeviceAttributeMultiprocessorCount, dev) != hipSuccess) { fprintf(stderr, "kernel_launch: device query failed\n"); return; }
        if (hipFuncSetAttribute((const void*)mk_fwd, hipFuncAttributeMaxDynamicSharedMemorySize, LDS_BYTES) != hipSuccess) { fprintf(stderr, "kernel_launch: hipFuncSetAttribute failed\n"); return; }
        g_grid = cus;
    }
    (void)hipMemsetAsync(ws + WS_CTL, 0, 65536, stream);
    MkArgs ma{}; ma.x = x; ma.pos = pos; ma.b_f = b_f; ma.final_norm = final_norm; for (int i = 0; i < 19; ++i) ma.in[i] = (const float*)d_in[i]; ma.H = (float*)d_out; ma.ws = ws;
    launch_mk(ma, 0, PH_TOTAL, stream);
}
```
